# Optimizing an MI355X kernel written in HIP

```python
import jax, jax.numpy as jnp
from jax import lax
import numpy as np

D_MODEL = 1024
BATCH = 16
SEQ = 4096
DEPTH = 2

POOL_WINDOWS = (2, 4, 8, 16)
POOL_GROUPS = len(POOL_WINDOWS)
POOL_WIDTH = D_MODEL // 2
POOL_GC = POOL_WIDTH // POOL_GROUPS
CONV_WIDTH = D_MODEL // 2
CONV_HEADS = 8
CONV_K = 3
EVEN_IN = POOL_WIDTH + 3 * CONV_WIDTH
EVEN_MIX = POOL_WIDTH + CONV_WIDTH
SGU_CHUNK = 128
SGU_WIDTH = 2 * D_MODEL
SGU_HEADS = 8
SGU_HD = SGU_WIDTH // SGU_HEADS
D_FF = 2816
FFN_K = 3
PLE_DIM = 256
N_EVEN = (DEPTH + 1) // 2
N_ODD = DEPTH // 2
DN_ALPHA = (2 * DEPTH) ** 0.25
DN_BETA = (8 * DEPTH) ** -0.25
LN_EPS = 1e-5

kernel_name = "hybrid_pool_shortconv_gmlp_deepnorm"


def layer_norm(x, g, b):
    xf = x.astype(jnp.float32)
    mu = jnp.mean(xf, axis=-1, keepdims=True)
    var = jnp.mean(jnp.square(xf - mu), axis=-1, keepdims=True)
    y = (xf - mu) * lax.rsqrt(var + LN_EPS)
    return (y * g.astype(jnp.float32) + b.astype(jnp.float32)).astype(x.dtype)


def causal_dwconv(h, w):
    K = w.shape[0]
    S = h.shape[1]
    hp = jnp.pad(h, ((0, 0), (K - 1, 0), (0, 0)))
    y = hp[:, 0:S] * w[0]
    for k in range(1, K):
        y = y + hp[:, k:k + S] * w[k]
    return y


def pool_mixer(h, mix, scale):
    Bn, S, _ = h.shape
    hg = h.reshape(Bn, S, POOL_GROUPS, POOL_GC).astype(jnp.float32)
    cs = jnp.cumsum(hg, axis=1)
    lagged = jnp.stack(
        [jnp.pad(cs[:, :S - w, g], ((0, 0), (w, 0), (0, 0)))
         for g, w in enumerate(POOL_WINDOWS)], axis=2)
    cnt = jnp.minimum(jnp.arange(1, S + 1, dtype=jnp.float32)[:, None],
                      jnp.array(POOL_WINDOWS, dtype=jnp.float32)[None, :])
    mean = (cs - lagged) / cnt[None, :, :, None]
    d = (mean - hg).astype(h.dtype)
    y = jnp.einsum('bsgc,gcd->bsgd', d, mix).reshape(Bn, S, POOL_WIDTH)
    return y * scale


def even_mixer(x, w_in, pool_mix, pool_scale, conv_w, w_out):
    z = x @ w_in
    h_a = z[..., :POOL_WIDTH]
    b_gate = z[..., POOL_WIDTH:POOL_WIDTH + CONV_WIDTH]
    c_gate = z[..., POOL_WIDTH + CONV_WIDTH:POOL_WIDTH + 2 * CONV_WIDTH]
    val = z[..., POOL_WIDTH + 2 * CONV_WIDTH:]
    y_a = pool_mixer(h_a, pool_mix, pool_scale)
    y_b = b_gate * causal_dwconv(c_gate * val, conv_w)
    return jnp.concatenate([y_a, y_b], axis=-1) @ w_out


def odd_mixer(x, w_in, ln_g, ln_b, sgu_w, sgu_b, w_out):
    Bn, S, _ = x.shape
    z = jax.nn.gelu(x @ w_in, approximate=False)
    u = z[..., :SGU_WIDTH]
    v = layer_norm(z[..., SGU_WIDTH:], ln_g, ln_b)
    v = v.reshape(Bn, S // SGU_CHUNK, SGU_CHUNK, SGU_HEADS, SGU_HD)
    causal = jnp.tril(jnp.ones((SGU_CHUNK, SGU_CHUNK), dtype=sgu_w.dtype))
    w_m = sgu_w * causal
    mixed = jnp.einsum('hts,bnshd->bnthd', w_m, v) + sgu_b.T[:, :, None]
    mixed = mixed.reshape(Bn, S, SGU_WIDTH)
    return (u * mixed) @ w_out


def conv_ffn(x, w_up, conv_w, conv_b, w_down):
    z = x @ w_up
    a = causal_dwconv(z[..., :D_FF], conv_w) + conv_b
    h = jax.nn.gelu(a, approximate=False) * z[..., D_FF:]
    return h @ w_down


def setup_inputs(seed: int = 0) -> dict:
    key = jax.random.key(seed)
    ks = jax.random.split(key, 32)
    f32 = jnp.float32
    nrm = lambda k, shape, s: jax.random.normal(k, shape, f32) * s
    return {
        "x": nrm(ks[0], (BATCH, SEQ, D_MODEL), 1.0),
        "p": nrm(ks[1], (DEPTH, BATCH, SEQ, PLE_DIM), 1.0),
        "even_w_in": nrm(ks[2], (N_EVEN, D_MODEL, EVEN_IN), D_MODEL ** -0.5),
        "even_pool_mix": nrm(ks[3], (N_EVEN, POOL_GROUPS, POOL_GC, POOL_GC), POOL_GC ** -0.5),
        "even_pool_scale": 1.0 + nrm(ks[4], (N_EVEN, POOL_WIDTH), 0.1),
        "even_conv_w": nrm(ks[5], (N_EVEN, CONV_K, CONV_WIDTH), CONV_K ** -0.5),
        "even_w_out": nrm(ks[6], (N_EVEN, EVEN_MIX, D_MODEL), EVEN_MIX ** -0.5 * DN_BETA),
        "odd_w_in": nrm(ks[7], (N_ODD, D_MODEL, 2 * SGU_WIDTH), D_MODEL ** -0.5),
        "odd_sgu_ln_g": 1.0 + nrm(ks[8], (N_ODD, SGU_WIDTH), 0.1),
        "odd_sgu_ln_b": nrm(ks[9], (N_ODD, SGU_WIDTH), 0.02),
        "odd_sgu_w": nrm(ks[10], (N_ODD, SGU_HEADS, SGU_CHUNK, SGU_CHUNK), SGU_CHUNK ** -0.5),
        "odd_sgu_b": 1.0 + nrm(ks[11], (N_ODD, SGU_HEADS, SGU_CHUNK), 0.1),
        "odd_w_out": nrm(ks[12], (N_ODD, SGU_WIDTH, D_MODEL), SGU_WIDTH ** -0.5 * DN_BETA),
        "mix_ln_g": 1.0 + nrm(ks[13], (DEPTH, D_MODEL), 0.1),
        "mix_ln_b": nrm(ks[14], (DEPTH, D_MODEL), 0.02),
        "ffn_w_up": nrm(ks[15], (DEPTH, D_MODEL, 2 * D_FF), D_MODEL ** -0.5),
        "ffn_conv_w": nrm(ks[16], (DEPTH, FFN_K, D_FF), FFN_K ** -0.5),
        "ffn_conv_b": nrm(ks[17], (DEPTH, D_FF), 0.02),
        "ffn_w_down": nrm(ks[18], (DEPTH, D_FF, D_MODEL), D_FF ** -0.5 * DN_BETA),
        "ffn_ln_g": 1.0 + nrm(ks[19], (DEPTH, D_MODEL), 0.1),
        "ffn_ln_b": nrm(ks[20], (DEPTH, D_MODEL), 0.02),
        "ple_w_gate": nrm(ks[21], (DEPTH, D_MODEL, D_MODEL), D_MODEL ** -0.5),
        "ple_b_gate": nrm(ks[22], (DEPTH, D_MODEL), 0.02),
        "ple_w_proj": nrm(ks[23], (DEPTH, PLE_DIM, D_MODEL), PLE_DIM ** -0.5),
    }


def reference(x, p, even_w_in, even_pool_mix, even_pool_scale, even_conv_w, even_w_out,
              odd_w_in, odd_sgu_ln_g, odd_sgu_ln_b, odd_sgu_w, odd_sgu_b, odd_w_out,
              mix_ln_g, mix_ln_b, ffn_w_up, ffn_conv_w, ffn_conv_b, ffn_w_down,
              ffn_ln_g, ffn_ln_b, ple_w_gate, ple_b_gate, ple_w_proj):
    for i in range(DEPTH):
        j = i // 2
        if i % 2 == 0:
            mixed = even_mixer(x, even_w_in[j], even_pool_mix[j], even_pool_scale[j],
                               even_conv_w[j], even_w_out[j])
        else:
            mixed = odd_mixer(x, odd_w_in[j], odd_sgu_ln_g[j], odd_sgu_ln_b[j],
                              odd_sgu_w[j], odd_sgu_b[j], odd_w_out[j])
        x = layer_norm(DN_ALPHA * x + mixed, mix_ln_g[i], mix_ln_b[i])
        ff = conv_ffn(x, ffn_w_up[i], ffn_conv_w[i], ffn_conv_b[i], ffn_w_down[i])
        x = layer_norm(DN_ALPHA * x + ff, ffn_ln_g[i], ffn_ln_b[i])
        gate = jax.nn.sigmoid(x @ ple_w_gate[i] + ple_b_gate[i])
        x = x + gate * (p[i] @ ple_w_proj[i])
    return x
```

```cpp
#include <hip/hip_runtime.h>
#include <hip/hip_cooperative_groups.h>
#include <cstdio>
namespace cg = cooperative_groups;
__device__ __forceinline__ int fresh_tid() { int t = (int)threadIdx.x; asm volatile("" : "+v"(t)); return t; }
__device__ __forceinline__ int fresh_bid() { int b = (int)blockIdx.x; asm volatile("" : "+s"(b)); return b; }
namespace pg8 {
#define PG8_LAS __attribute__((address_space(3)))
typedef unsigned short bf16_t;
typedef short bf16x8 __attribute__((ext_vector_type(8)));
typedef float f32x4 __attribute__((ext_vector_type(4)));
typedef unsigned u32x4 __attribute__((ext_vector_type(4)));
constexpr int BM = 256, BK = 64, HALF = 128, HTB = HALF * BK * 2  , STAGE_BYTES = 8 * HTB, NXCD = 8, WGM = 8;

__host__ __device__ __forceinline__ int lds_byte(int r, int c) { const int st = (r >> 4) * 2 + (c >> 5), rr = r & 15, cc = c & 31, ob = rr * 64 + cc * 2; return st * 1024 + (ob ^ (((ob >> 9) & 1) << 5)); }
__host__ __device__ __forceinline__ void stage_rc(int b, int& R, int& C) { const int st = b / 1024, sb = b % 1024, swz = sb ^ (((sb >> 9) & 1) << 5); R = (st >> 1) * 16 + swz / 64; C = (st & 1) * 32 + (swz % 64) / 2; }
__host__ __device__ __forceinline__ int perm32(int rho) { const int n = rho >> 4, i = rho & 15; return 8 * (i >> 2) + 4 * n + (i & 3); }

struct Unit { int pm, pn; };
struct Gemm { const bf16_t* A; const bf16_t* Bt; int M, N, K; };

struct StaticOrder {
    int nM, nN, nwg, G, c;
    __host__ __device__ void init(int M, int N, int G_, int c_) { nM = M / BM; nN = N / BM; nwg = nM * nN; G = G_; c = c_; }
    __host__ __device__ bool next(int i, Unit& u) const {
        const long L = (long)i * G + c; if (L >= nwg) return false;
        int wgid = (int)L; { const int q = nwg / NXCD, r = nwg % NXCD, xcd = wgid % NXCD, off = wgid / NXCD; wgid = (xcd < r ? xcd * (q + 1) : r * (q + 1) + (xcd - r) * q) + off; }
        const int nig = WGM * nN, gid = wgid / nig, fm = gid * WGM, gsz = (nM - fm) < WGM ? (nM - fm) : WGM;
        u.pm = fm + ((wgid % nig) % gsz); u.pn = (wgid % nig) / gsz; return true;
    }
    __device__ __forceinline__ void a_ready(const Unit&) const {}
    __device__ __forceinline__ void done(const Unit&) const {}
};
__device__ __forceinline__ unsigned cvt_pk_bf16(float lo, float hi) { unsigned r; asm volatile("v_cvt_pk_bf16_f32 %0, %1, %2" : "=v"(r) : "v"(lo), "v"(hi)); return r; }
typedef float f32x2 __attribute__((ext_vector_type(2)));
__device__ __forceinline__ f32x2 gelu_pk(f32x2 v) {
    const f32x2 av = __builtin_elementwise_abs(v), d = av * 0.2316418882f + 1.0f;
    f32x2 t; t.x = __builtin_amdgcn_rcpf(d.x); t.y = __builtin_amdgcn_rcpf(d.y);
    f32x2 q = t * 0.5307027145f + (-0.7265760135f); q = q * t + 0.7107068705f; q = q * t + (-0.142248368f); q = q * t + 0.127414796f; q = q * t;
    const f32x2 s = (v * v) * (-0.72134752044f);
    f32x2 e; e.x = __builtin_amdgcn_exp2f(s.x); e.y = __builtin_amdgcn_exp2f(s.y);
    const f32x2 m = v * (q * e), r = v - m;
    f32x2 o; o.x = v.x < 0.f ? m.x : r.x; o.y = v.y < 0.f ? m.y : r.y; return o;
}

struct EpiF32 {
    static constexpr bool PERM = false, AFTER_DRAIN = false;
    float* C; int ldc; const float* bias;
    __device__ __forceinline__ void operator()(const f32x4 (&acc)[2][2][4][2], const Unit& u, int wr, int wc, int fr, int fq) const {
        const int row0 = u.pm * BM + wr * 64 + fr, col0 = u.pn * BM + wc * 32 + 4 * fq;
        f32x4 bv[2][2];
#pragma unroll
        for (int bj = 0; bj < 2; ++bj)
#pragma unroll
            for (int n = 0; n < 2; ++n) bv[bj][n] = bias ? *(const f32x4*)(bias + col0 + bj * HALF + n * 16) : (f32x4){0.f, 0.f, 0.f, 0.f};
#pragma unroll
        for (int ai = 0; ai < 2; ++ai)
#pragma unroll
            for (int m = 0; m < 4; ++m) { float* rowp = C + (size_t)(row0 + ai * HALF + m * 16) * ldc + col0;
#pragma unroll
                for (int bj = 0; bj < 2; ++bj)
#pragma unroll
                    for (int n = 0; n < 2; ++n) *(f32x4*)(rowp + bj * HALF + n * 16) = acc[ai][bj][m][n] + bv[bj][n]; }
    }
};
template <int ACT  > struct EpiBf16 {
    static constexpr bool PERM = true, AFTER_DRAIN = false;
    bf16_t* O; int ldc; const float* bias; int split_cols; size_t split_stride;
    __device__ __forceinline__ void operator()(const f32x4 (&acc)[2][2][4][2], const Unit& u, int wr, int wc, int fr, int fq) const {
        const int row0 = u.pm * BM + wr * 64 + fr; int colt = u.pn * BM; bf16_t* base = O;
        if (split_cols) { const int t = colt / split_cols; base += (size_t)t * split_stride; colt -= t * split_cols; }
        const int col0 = colt + wc * 32 + 8 * fq, bcol0 = u.pn * BM + wc * 32 + 8 * fq;
        f32x4 bv[2][2];
#pragma unroll
        for (int bj = 0; bj < 2; ++bj)
#pragma unroll
            for (int n = 0; n < 2; ++n) bv[bj][n] = bias ? *(const f32x4*)(bias + bcol0 + bj * HALF + 4 * n) : (f32x4){0.f, 0.f, 0.f, 0.f};
#pragma unroll
        for (int ai = 0; ai < 2; ++ai)
#pragma unroll
            for (int m = 0; m < 4; ++m) { bf16_t* rowp = base + (size_t)(row0 + ai * HALF + m * 16) * ldc + col0;
#pragma unroll
                for (int bj = 0; bj < 2; ++bj) { f32x4 v0 = acc[ai][bj][m][0] + bv[bj][0], v1 = acc[ai][bj][m][1] + bv[bj][1];
                    if (ACT == 1) { f32x2 a = gelu_pk((f32x2){v0[0], v0[1]}), b = gelu_pk((f32x2){v0[2], v0[3]}), c = gelu_pk((f32x2){v1[0], v1[1]}), d = gelu_pk((f32x2){v1[2], v1[3]});
                        v0 = (f32x4){a.x, a.y, b.x, b.y}; v1 = (f32x4){c.x, c.y, d.x, d.y}; }
                    if (ACT == 2) {
#pragma unroll
                        for (int j = 0; j < 4; ++j) { v0[j] = 0.5f * v0[j] * (1.0f + erff(v0[j] * 0.70710678f)); v1[j] = 0.5f * v1[j] * (1.0f + erff(v1[j] * 0.70710678f)); } }
                    u32x4 w; w.x = cvt_pk_bf16(v0[0], v0[1]); w.y = cvt_pk_bf16(v0[2], v0[3]); w.z = cvt_pk_bf16(v1[0], v1[1]); w.w = cvt_pk_bf16(v1[2], v1[3]);
                    *(u32x4*)(rowp + bj * HALF) = w; } }
    }
};
struct EpiRes {
    static constexpr bool PERM = false, AFTER_DRAIN = false;
    const float* base; float* out; int ldc; float alpha;
    __device__ __forceinline__ void operator()(const f32x4 (&acc)[2][2][4][2], const Unit& u, int wr, int wc, int fr, int fq) const {
        const int row0 = u.pm * BM + wr * 64 + fr, col0 = u.pn * BM + wc * 32 + 4 * fq;
#pragma unroll
        for (int ai = 0; ai < 2; ++ai)
#pragma unroll
            for (int m = 0; m < 4; ++m) { const size_t off = (size_t)(row0 + ai * HALF + m * 16) * ldc + col0;
#pragma unroll
                for (int bj = 0; bj < 2; ++bj)
#pragma unroll
                    for (int n = 0; n < 2; ++n) { const f32x4 bs = *(const f32x4*)(base + off + bj * HALF + n * 16);
                        *(f32x4*)(out + off + bj * HALF + n * 16) = bs * alpha + acc[ai][bj][m][n]; }
                asm volatile("" ::: "memory"); }
    }
};
struct EpiPle {
    static constexpr bool PERM = false, AFTER_DRAIN = false;
    float* R; const float* PP; const float* bg; bf16_t* xb; int ldc;
    __device__ __forceinline__ void operator()(const f32x4 (&acc)[2][2][4][2], const Unit& u, int wr, int wc, int fr, int fq) const {
        typedef unsigned u32x2v __attribute__((ext_vector_type(2)));
        const int row0 = u.pm * BM + wr * 64 + fr, col0 = u.pn * BM + wc * 32 + 4 * fq;
        f32x4 bv[2][2];
#pragma unroll
        for (int bj = 0; bj < 2; ++bj)
#pragma unroll
            for (int n = 0; n < 2; ++n) bv[bj][n] = *(const f32x4*)(bg + col0 + bj * HALF + n * 16);
#pragma unroll
        for (int ai = 0; ai < 2; ++ai)
#pragma unroll
            for (int m = 0; m < 4; ++m) { const size_t off = (size_t)(row0 + ai * HALF + m * 16) * ldc + col0;
#pragma unroll
                for (int bj = 0; bj < 2; ++bj)
#pragma unroll
                    for (int n = 0; n < 2; ++n) { const size_t p = off + bj * HALF + n * 16;
                        const f32x4 x = *(const f32x4*)(R + p), pp = *(const f32x4*)(PP + p); const f32x4 a = acc[ai][bj][m][n] + bv[bj][n]; f32x4 o;
#pragma unroll
                        for (int j = 0; j < 4; ++j) { const float e = __builtin_amdgcn_exp2f(a[j] * -1.44269504089f); o[j] = x[j] + pp[j] * __builtin_amdgcn_rcpf(1.0f + e); }
                        *(f32x4*)(R + p) = o;
                        if (xb) { u32x2v w; w.x = cvt_pk_bf16(o[0], o[1]); w.y = cvt_pk_bf16(o[2], o[3]); *(u32x2v*)(xb + p) = w; } }
                asm volatile("" ::: "memory"); }
    }
};
template <class Epi, class Sched, bool STAMP = false>
__device__ __forceinline__ void gemm_phase(PG8_LAS unsigned char* lds, const Gemm g, const Sched& S, const Epi& E, unsigned long long* stamps) {
    const int tid = fresh_tid(), wid = __builtin_amdgcn_readfirstlane(tid >> 6), lane = tid & 63, wr = wid >> 2, wc = wid & 3, fr = lane & 15, fq = lane >> 4;
    const int K = g.K, nt = K / BK;
    int ts_lo = 0, ts_hi = 0, nts = 0; const unsigned long long rt_entry = STAMP ? (unsigned long long)wall_clock64() : 0ull;
#define PG8_STAMP() do { if (STAMP && wid == 0 && nts < 64) { const unsigned long long _c = (unsigned long long)clock64(); \
        ts_lo = (lane == nts) ? (int)(unsigned)_c : ts_lo; ts_hi = (lane == nts) ? (int)(unsigned)(_c >> 32) : ts_hi; ++nts; } } while (0)
    PG8_STAMP();
    unsigned voffA[2], voffB[2];
#pragma unroll
    for (int i = 0; i < 2; ++i) { int R, C; stage_rc(tid * 16 + i * 8192, R, C); const int Rb = Epi::PERM ? ((R & ~31) + perm32(R & 31)) : R;
        voffA[i] = (unsigned)(R * K + C) * 2u; voffB[i] = (unsigned)(Rb * K + C) * 2u; }
    const size_t kstep = (size_t)(BK * 2);
    const size_t hstep = (size_t)HALF * K * 2;
    const size_t tstep = 2 * hstep;
    const unsigned ldsw = (unsigned)wid * 1024u;
    const int aoff = lds_byte(wr * 64 + fr, fq * 8), boff = lds_byte(wc * 32 + fr, fq * 8);
#define PG8_SA(b, h) (((b) * 2 + (h)) * HTB)
#define PG8_SB(b, h) ((4 + (b) * 2 + (h)) * HTB)
#define PG8_STAGE(bufoff, gbase, voff) do { _Pragma("unroll") for (int _i = 0; _i < 2; ++_i) \
        __builtin_amdgcn_global_load_lds((const unsigned*)((const char*)(gbase) + (voff)[_i]), (PG8_LAS unsigned*)(lds + (bufoff) + ldsw + _i * 8192), 16, 0, 0); } while (0)
#define PG8_LDA(dst, b, h) do { _Pragma("unroll") for (int m = 0; m < 4; ++m) _Pragma("unroll") for (int k = 0; k < 2; ++k) dst[m][k] = *(const PG8_LAS bf16x8*)(lds + PG8_SA(b, h) + aoff + m * 2048 + k * 1024); } while (0)
#define PG8_LDB(dst, b, h) do { _Pragma("unroll") for (int n = 0; n < 2; ++n) _Pragma("unroll") for (int k = 0; k < 2; ++k) dst[n][k] = *(const PG8_LAS bf16x8*)(lds + PG8_SB(b, h) + boff + n * 2048 + k * 1024); } while (0)
#define PG8_MMA(ai, bj, At, Bt) do { __builtin_amdgcn_s_setprio(1); _Pragma("unroll") for (int m = 0; m < 4; ++m) _Pragma("unroll") for (int n = 0; n < 2; ++n) _Pragma("unroll") for (int k = 0; k < 2; ++k) \
        acc[ai][bj][m][n] = __builtin_amdgcn_mfma_f32_16x16x32_bf16(Bt[n][k], At[m][k], acc[ai][bj][m][n], 0, 0, 0); __builtin_amdgcn_s_setprio(0); } while (0)
#define PG8_WAIT_V(n) asm volatile("s_waitcnt vmcnt(" #n ")" ::: "memory")
#define PG8_WAIT_L(n) asm volatile("s_waitcnt lgkmcnt(" #n ")" ::: "memory")
#define PG8_BAR __builtin_amdgcn_s_barrier()
#define PG8_SCHED __builtin_amdgcn_sched_barrier(0)
    Unit cur, nxt; int ui = 0;
    if (!S.next(0, cur)) return;
    f32x4 acc[2][2][4][2];
#pragma unroll
    for (int a = 0; a < 2; ++a)
#pragma unroll
        for (int b = 0; b < 2; ++b)
#pragma unroll
            for (int m = 0; m < 4; ++m)
#pragma unroll
                for (int n = 0; n < 2; ++n) acc[a][b][m][n] = (f32x4){0.f, 0.f, 0.f, 0.f};
    bf16x8 At[4][2], B0[2][2], B1[2][2];
    const char* cA = (const char*)g.A + (size_t)cur.pm * tstep; const char* cB = (const char*)g.Bt + (size_t)cur.pn * tstep;
    S.a_ready(cur);
    PG8_STAGE(PG8_SB(0, 0), cB, voffB); PG8_STAGE(PG8_SA(0, 0), cA, voffA); PG8_STAGE(PG8_SB(0, 1), cB + hstep, voffB); PG8_STAGE(PG8_SA(0, 1), cA + hstep, voffA);
    if (wr == 1) PG8_BAR;
    PG8_WAIT_V(4); PG8_BAR;
    PG8_STAGE(PG8_SB(1, 0), cB + kstep, voffB); PG8_STAGE(PG8_SA(1, 0), cA + kstep, voffA); PG8_STAGE(PG8_SB(1, 1), cB + hstep + kstep, voffB);
    PG8_WAIT_V(6); PG8_BAR;
    PG8_STAMP();
    for (;;) {
        const bool has_next = S.next(ui + 1, nxt);
        const char* nA = has_next ? (const char*)g.A + (size_t)nxt.pm * tstep : cA; const char* nB = has_next ? (const char*)g.Bt + (size_t)nxt.pn * tstep : cB;
        for (int t = 0; t < nt; t += 2) {
            const bool last = (t == nt - 2);
            const char* a1 = cA + (size_t)(t + 1) * kstep;
            const char* a2 = last ? nA : cA + (size_t)(t + 2) * kstep; const char* b2 = last ? nB : cB + (size_t)(t + 2) * kstep;
            const char* a3 = a2 + kstep; const char* b3 = b2 + kstep;
            if (last && has_next) S.a_ready(nxt);
            PG8_LDB(B0, 0, 0); PG8_SCHED; PG8_LDA(At, 0, 0); PG8_STAGE(PG8_SA(1, 1), a1 + hstep, voffA);
            PG8_WAIT_L(8); PG8_BAR; PG8_WAIT_L(0); PG8_MMA(0, 0, At, B0); PG8_BAR; PG8_SCHED;
            PG8_LDB(B1, 0, 1); PG8_STAGE(PG8_SB(0, 0), b2, voffB);
            PG8_BAR; PG8_WAIT_L(0); PG8_MMA(0, 1, At, B1); PG8_BAR;
            PG8_LDA(At, 0, 1); PG8_STAGE(PG8_SA(0, 0), a2, voffA);
            PG8_BAR; PG8_WAIT_L(0); PG8_MMA(1, 0, At, B0); PG8_BAR; PG8_SCHED;
            PG8_STAGE(PG8_SB(0, 1), b2 + hstep, voffB);
            PG8_WAIT_V(6); PG8_BAR; PG8_MMA(1, 1, At, B1); PG8_BAR;
            PG8_LDB(B0, 1, 0); PG8_SCHED; PG8_LDA(At, 1, 0); PG8_STAGE(PG8_SA(0, 1), a2 + hstep, voffA);
            PG8_WAIT_L(8); PG8_BAR; PG8_WAIT_L(0); PG8_MMA(0, 0, At, B0); PG8_BAR; PG8_SCHED;
            PG8_LDB(B1, 1, 1); PG8_STAGE(PG8_SB(1, 0), b3, voffB);
            PG8_BAR; PG8_WAIT_L(0); PG8_MMA(0, 1, At, B1); PG8_BAR;
            PG8_LDA(At, 1, 1); PG8_STAGE(PG8_SA(1, 0), a3, voffA);
            PG8_BAR; PG8_WAIT_L(0); PG8_MMA(1, 0, At, B0); PG8_BAR; PG8_SCHED;
            PG8_STAGE(PG8_SB(1, 1), b3 + hstep, voffB);
            PG8_WAIT_V(6); PG8_BAR; PG8_MMA(1, 1, At, B1); PG8_BAR;
        }
        PG8_STAMP();
        if constexpr (!Epi::AFTER_DRAIN) { E(acc, cur, wr, wc, fr, fq); S.done(cur); }
        PG8_STAMP();
        if (!has_next) break;
#pragma unroll
        for (int a = 0; a < 2; ++a)
#pragma unroll
            for (int b = 0; b < 2; ++b)
#pragma unroll
                for (int m = 0; m < 4; ++m)
#pragma unroll
                    for (int n = 0; n < 2; ++n) acc[a][b][m][n] = (f32x4){0.f, 0.f, 0.f, 0.f};
        cur = nxt; cA = nA; cB = nB; ++ui;
    }
    PG8_WAIT_V(0);
    if (wr == 0) PG8_BAR;
    PG8_BAR;
    if constexpr (Epi::AFTER_DRAIN) { E.fused(acc, cur, wr, wc, fr, fq, lds, wid, lane); S.done(cur); }
    PG8_STAMP();
    if (STAMP && wid == 0) { stamps[lane] = lane < nts ? (((unsigned long long)(unsigned)ts_hi << 32) | (unsigned)ts_lo) : 0ull;
        if (lane == 62) stamps[62] = rt_entry; if (lane == 63) stamps[63] = (unsigned long long)wall_clock64(); }
#undef PG8_STAMP
#undef PG8_SA
#undef PG8_SB
#undef PG8_STAGE
#undef PG8_LDA
#undef PG8_LDB
#undef PG8_MMA
#undef PG8_WAIT_V
#undef PG8_WAIT_L
#undef PG8_BAR
#undef PG8_SCHED
}
}

typedef pg8::bf16_t bf16_t;
typedef pg8::bf16x8 bf16x8;
typedef pg8::f32x4 f32x4;
typedef float f32x2 __attribute__((ext_vector_type(2)));
constexpr int MTOK = 65536, DM = 1024, SEQL = 4096, EIN = 2048, DFF = 2816, SGUW_ = 2048, PLE = 256;
constexpr int MH = MTOK / 2;
constexpr float ALPHA = 1.41421356237f, LNEPS = 1e-5f;
constexpr int LDS_BYTES = pg8::STAGE_BYTES;

constexpr size_t al256(size_t x) { return (x + 255) & ~(size_t)255; }
constexpr size_t OFF_WT_EIN = 0;
constexpr size_t OFF_WT_EOUT = OFF_WT_EIN + (size_t)EIN * DM * 2;
constexpr size_t OFF_WT_OIN = OFF_WT_EOUT + (size_t)DM * DM * 2;
constexpr size_t OFF_WT_OOUT = OFF_WT_OIN + (size_t)4096 * DM * 2;
constexpr size_t OFF_WT_UP = OFF_WT_OOUT + (size_t)DM * 2048 * 2;
constexpr size_t SZ_WT_UP = (size_t)2 * DFF * DM * 2;
constexpr size_t OFF_WT_DOWN = OFF_WT_UP + 2 * SZ_WT_UP;
constexpr size_t SZ_WT_DOWN = (size_t)DM * DFF * 2;
constexpr size_t OFF_WT_GATE = OFF_WT_DOWN + 2 * SZ_WT_DOWN;
constexpr size_t SZ_WT_GATE = (size_t)DM * DM * 2;
constexpr size_t OFF_WT_PROJ = OFF_WT_GATE + 2 * SZ_WT_GATE;
constexpr size_t SZ_WT_PROJ = (size_t)DM * PLE * 2;
constexpr size_t OFF_SGUW = OFF_WT_PROJ + 2 * SZ_WT_PROJ;
constexpr size_t OFF_ACTB = al256(OFF_SGUW + (size_t)8 * 128 * 128 * 2);
constexpr size_t OFF_PB = OFF_ACTB + (size_t)MTOK * DM * 2;
constexpr size_t OFF_ZBUF = OFF_PB + (size_t)MTOK * PLE * 2;
constexpr size_t OFF_HF = OFF_ZBUF + (size_t)MTOK * 4096 * 2;
constexpr size_t WS_END = OFF_HF + (size_t)MTOK * 2048 * 2;

struct Params { const float* in[24]; float* out; unsigned char* ws; };

__device__ __forceinline__ unsigned pk2(float lo, float hi) { return pg8::cvt_pk_bf16(lo, hi); }
__device__ __forceinline__ float bflo(unsigned u) { return __uint_as_float(u << 16); }
__device__ __forceinline__ float bfhi(unsigned u) { return __uint_as_float(u & 0xffff0000u); }
__device__ __forceinline__ unsigned short f2bf(float f) { unsigned u = __float_as_uint(f); u += 0x7FFFu + ((u >> 16) & 1u); return (unsigned short)(u >> 16); }
__device__ __forceinline__ void unpack8(const uint4 d, float (&f)[8]) {
    f[0] = bflo(d.x); f[1] = bfhi(d.x); f[2] = bflo(d.y); f[3] = bfhi(d.y); f[4] = bflo(d.z); f[5] = bfhi(d.z); f[6] = bflo(d.w); f[7] = bfhi(d.w); }
__device__ __forceinline__ uint4 pack8(const float (&f)[8]) { uint4 o; o.x = pk2(f[0], f[1]); o.y = pk2(f[2], f[3]); o.z = pk2(f[4], f[5]); o.w = pk2(f[6], f[7]); return o; }

__device__ __forceinline__ void transpose_w(float* tile, const float* __restrict__ src, int lds_, bf16_t* __restrict__ dst, int ldd, int K, int N) {
    const int tid = fresh_tid(); const int tn = N / 64, nt = (K / 64) * tn;
    for (int tix = fresh_bid(); tix < nt; tix += gridDim.x) {
        const int k0 = (tix / tn) * 64, n0 = (tix % tn) * 64;
#pragma unroll
        for (int p = 0; p < 2; ++p) { const int kk = (tid >> 4) + p * 32, n4 = (tid & 15) * 4;
            const float4 v = *(const float4*)(src + (size_t)(k0 + kk) * lds_ + n0 + n4);
            float* t = tile + kk * 65 + n4; t[0] = v.x; t[1] = v.y; t[2] = v.z; t[3] = v.w; }
        __syncthreads();
        { const int nn = tid >> 3, k8 = (tid & 7) * 8; float f[8];
#pragma unroll
          for (int j = 0; j < 8; ++j) f[j] = tile[(k8 + j) * 65 + nn];
          *(uint4*)(dst + (size_t)(n0 + nn) * ldd + k0 + k8) = pack8(f); }
        __syncthreads();
    }
}
__device__ __forceinline__ void convert_bf16(const float* __restrict__ src, bf16_t* __restrict__ dst, size_t n) {
    const size_t n8 = n / 8;
    for (size_t i = (size_t)fresh_bid() * 512 + fresh_tid(); i < n8; i += (size_t)gridDim.x * blockDim.x) {
        const float4 a = *(const float4*)(src + i * 8), b = *(const float4*)(src + i * 8 + 4);
        uint4 o; o.x = pk2(a.x, a.y); o.y = pk2(a.z, a.w); o.z = pk2(b.x, b.y); o.w = pk2(b.z, b.w);
        *(uint4*)(dst + i * 8) = o; }
}

__device__ __forceinline__ void prep_phase(const Params& P, float* tile) {
    unsigned char* ws = P.ws;
    transpose_w(tile, P.in[2], EIN, (bf16_t*)(ws + OFF_WT_EIN), DM, DM, EIN);
    transpose_w(tile, P.in[6] + (size_t)512 * DM, DM, (bf16_t*)(ws + OFF_WT_EOUT) + 512, DM, 512, DM);
    transpose_w(tile, P.in[7], 4096, (bf16_t*)(ws + OFF_WT_OIN), DM, DM, 4096);
    transpose_w(tile, P.in[12], DM, (bf16_t*)(ws + OFF_WT_OOUT), 2048, 2048, DM);
    for (int l = 0; l < 2; ++l) {
        transpose_w(tile, P.in[15] + (size_t)l * DM * 2 * DFF, 2 * DFF, (bf16_t*)(ws + OFF_WT_UP + l * SZ_WT_UP), DM, DM, 2 * DFF);
        transpose_w(tile, P.in[18] + (size_t)l * DFF * DM, DM, (bf16_t*)(ws + OFF_WT_DOWN + l * SZ_WT_DOWN), DFF, DFF, DM);
        transpose_w(tile, P.in[21] + (size_t)l * DM * DM, DM, (bf16_t*)(ws + OFF_WT_GATE + l * SZ_WT_GATE), DM, DM, DM);
        transpose_w(tile, P.in[23] + (size_t)l * PLE * DM, DM, (bf16_t*)(ws + OFF_WT_PROJ + l * SZ_WT_PROJ), PLE, PLE, DM);
    }
    const size_t gt = (size_t)fresh_bid() * 512 + fresh_tid(), gs = (size_t)gridDim.x * blockDim.x;
    { const float* mix = P.in[3]; const float* sc = P.in[4]; const float* wo = P.in[6]; bf16_t* dst = (bf16_t*)(ws + OFF_WT_EOUT);
      for (size_t it = gt; it < (size_t)512 * DM; it += gs) { const int k = (int)(it >> 10), n = (int)(it & 1023), g = k >> 7;
          const float* mrow = mix + (size_t)k * 128; const float* srow = sc + g * 128; const float* wcol = wo + (size_t)(g * 128) * DM + n; float s = 0.f;
          for (int d = 0; d < 128; ++d) s += mrow[d] * srow[d] * wcol[(size_t)d * DM];
          dst[(size_t)n * DM + k] = f2bf(s); } }
    { const float* w = P.in[10]; bf16_t* dst = (bf16_t*)(ws + OFF_SGUW);
      for (size_t it = gt; it < (size_t)8 * 128 * 128; it += gs) { const int t = (int)((it >> 7) & 127), s = (int)(it & 127); dst[it] = (s <= t) ? f2bf(w[it]) : (bf16_t)0; } }
    convert_bf16(P.in[0], (bf16_t*)(ws + OFF_ACTB), (size_t)MTOK * DM);
    convert_bf16(P.in[1], (bf16_t*)(ws + OFF_PB), (size_t)MTOK * PLE);
}

__device__ __forceinline__ void mixer0_phase(const bf16_t* __restrict__ Z, const float* __restrict__ cw, bf16_t* __restrict__ O) {
    const size_t total = (size_t)MTOK * 128;
    for (size_t it = (size_t)fresh_bid() * 512 + fresh_tid(); it < total; it += (size_t)gridDim.x * blockDim.x) {
        const int r = (int)(it >> 7), cgp = (int)(it & 127), t = r & (SEQL - 1); float o[8];
        if (cgp < 64) {
            const int c0 = cgp * 8, w = 2 << (c0 >> 7), cnt = (t + 1 < w) ? t + 1 : w; float x[8], s[8];
            unpack8(*(const uint4*)(Z + (size_t)r * EIN + c0), x);
#pragma unroll
            for (int j = 0; j < 8; ++j) s[j] = x[j];
            for (int i = 1; i < cnt; ++i) { float y[8]; unpack8(*(const uint4*)(Z + (size_t)(r - i) * EIN + c0), y);
#pragma unroll
                for (int j = 0; j < 8; ++j) s[j] += y[j]; }
            const float inv = 1.0f / (float)cnt;
#pragma unroll
            for (int j = 0; j < 8; ++j) o[j] = s[j] * inv - x[j];
        } else {
            const int c0 = (cgp - 64) * 8; float bg[8];
            unpack8(*(const uint4*)(Z + (size_t)r * EIN + 512 + c0), bg);
#pragma unroll
            for (int j = 0; j < 8; ++j) o[j] = 0.f;
#pragma unroll
            for (int k = 0; k < 3; ++k) { if (t - 2 + k >= 0) { float cgv[8], vv[8]; const size_t ro = (size_t)(r - 2 + k) * EIN;
                unpack8(*(const uint4*)(Z + ro + 1024 + c0), cgv); unpack8(*(const uint4*)(Z + ro + 1536 + c0), vv);
                const float4 w0 = *(const float4*)(cw + k * 512 + c0), w1 = *(const float4*)(cw + k * 512 + c0 + 4);
                const float wk[8] = {w0.x, w0.y, w0.z, w0.w, w1.x, w1.y, w1.z, w1.w};
#pragma unroll
                for (int j = 0; j < 8; ++j) o[j] += wk[j] * (cgv[j] * vv[j]); } }
#pragma unroll
            for (int j = 0; j < 8; ++j) o[j] *= bg[j];
        }
        *(uint4*)(O + (size_t)r * DM + cgp * 8) = pack8(o);
    }
}

__device__ __forceinline__ void ln_phase(float* __restrict__ R, const float* __restrict__ g, const float* __restrict__ b, bf16_t* __restrict__ XB) {
    const int tid_ = fresh_tid(); const int lane = tid_ & 63, wave = tid_ >> 6;
    float4 gv[4], bv[4];
#pragma unroll
    for (int i = 0; i < 4; ++i) { gv[i] = *(const float4*)(g + i * 256 + lane * 4); bv[i] = *(const float4*)(b + i * 256 + lane * 4); }
    for (int row = fresh_bid() * 8 + wave; row < MTOK; row += gridDim.x * 8) {
        float* rp = R + (size_t)row * DM; float4 v[4]; float s = 0.f;
#pragma unroll
        for (int i = 0; i < 4; ++i) { v[i] = *(const float4*)(rp + i * 256 + lane * 4); s += (v[i].x + v[i].y) + (v[i].z + v[i].w); }
#pragma unroll
        for (int o = 32; o >= 1; o >>= 1) s += __shfl_xor(s, o);
        const float mean = s * (1.0f / DM); float q = 0.f;
#pragma unroll
        for (int i = 0; i < 4; ++i) { v[i].x -= mean; v[i].y -= mean; v[i].z -= mean; v[i].w -= mean; q += (v[i].x * v[i].x + v[i].y * v[i].y) + (v[i].z * v[i].z + v[i].w * v[i].w); }
#pragma unroll
        for (int o = 32; o >= 1; o >>= 1) q += __shfl_xor(q, o);
        const float rstd = 1.0f / sqrtf(q * (1.0f / DM) + LNEPS);
#pragma unroll
        for (int i = 0; i < 4; ++i) { float4 y; y.x = v[i].x * rstd * gv[i].x + bv[i].x; y.y = v[i].y * rstd * gv[i].y + bv[i].y; y.z = v[i].z * rstd * gv[i].z + bv[i].z; y.w = v[i].w * rstd * gv[i].w + bv[i].w;
            *(float4*)(rp + i * 256 + lane * 4) = y; uint2 w; w.x = pk2(y.x, y.y); w.y = pk2(y.z, y.w); *(uint2*)(XB + (size_t)row * DM + i * 256 + lane * 4) = w; }
    }
}

__device__ __forceinline__ void ffnconv_phase(const bf16_t* __restrict__ ZF, const float* __restrict__ cw, const float* __restrict__ cb, bf16_t* __restrict__ HF) {
    const size_t total = (size_t)MH * 352;
    for (size_t it = (size_t)fresh_bid() * 512 + fresh_tid(); it < total; it += (size_t)gridDim.x * blockDim.x) {
        const int r = (int)(it / 352), c0 = (int)(it % 352) * 8, t = r & (SEQL - 1); float a[8], gg[8];
        { const float4 b0 = *(const float4*)(cb + c0), b1 = *(const float4*)(cb + c0 + 4); a[0] = b0.x; a[1] = b0.y; a[2] = b0.z; a[3] = b0.w; a[4] = b1.x; a[5] = b1.y; a[6] = b1.z; a[7] = b1.w; }
#pragma unroll
        for (int k = 0; k < 3; ++k) { if (t - 2 + k >= 0) { float z[8]; unpack8(*(const uint4*)(ZF + (size_t)(r - 2 + k) * (2 * DFF) + c0), z);
            const float4 w0 = *(const float4*)(cw + k * DFF + c0), w1 = *(const float4*)(cw + k * DFF + c0 + 4);
            const float wk[8] = {w0.x, w0.y, w0.z, w0.w, w1.x, w1.y, w1.z, w1.w};
#pragma unroll
            for (int j = 0; j < 8; ++j) a[j] += wk[j] * z[j]; } }
        unpack8(*(const uint4*)(ZF + (size_t)r * (2 * DFF) + DFF + c0), gg); float o[8];
#pragma unroll
        for (int j = 0; j < 8; j += 2) { const f32x2 ge = pg8::gelu_pk((f32x2){a[j], a[j + 1]}); o[j] = ge.x * gg[j]; o[j + 1] = ge.y * gg[j + 1]; }
        *(uint4*)(HF + (size_t)r * DFF + c0) = pack8(o);
    }
}

constexpr int SG_PITCH = 136;
__device__ __forceinline__ void sgu_phase(unsigned char* lds, const bf16_t* __restrict__ Z, const bf16_t* __restrict__ Wm, const float* __restrict__ lng, const float* __restrict__ lnb,
                                          const float* __restrict__ sb, bf16_t* __restrict__ UM) {
    const int tid = fresh_tid(), lane = tid & 63, wave = tid >> 6, l15 = lane & 15, quad = lane >> 4;
    f32x2* stats = (f32x2*)lds;
    bf16_t* Wl = (bf16_t*)(lds + 1024);
    bf16_t* vT = (bf16_t*)(lds + 1024 + 128 * SG_PITCH * 2);
    for (int ch = fresh_bid(); ch < MTOK / 128; ch += gridDim.x) {
        const size_t R0 = (size_t)ch * 128;
        for (int i = 0; i < 16; ++i) { const int row = wave * 16 + i; const bf16_t* vp = Z + (R0 + row) * 4096 + 2048; float s = 0.f, ss = 0.f;
#pragma unroll
            for (int q = 0; q < 4; ++q) { float f[8]; unpack8(*(const uint4*)(vp + q * 512 + lane * 8), f);
#pragma unroll
                for (int j = 0; j < 8; ++j) { s += f[j]; ss += f[j] * f[j]; } }
#pragma unroll
            for (int o = 32; o >= 1; o >>= 1) { s += __shfl_xor(s, o); ss += __shfl_xor(ss, o); }
            const float mean = s * (1.0f / 2048.0f), var = fmaxf(ss * (1.0f / 2048.0f) - mean * mean, 0.f);
            if (lane == 0) stats[row] = (f32x2){mean, 1.0f / sqrtf(var + LNEPS)}; }
        __syncthreads();
        for (int h = 0; h < 8; ++h) {
#pragma unroll
            for (int i = 0; i < 4; ++i) { const int idx = tid + i * 512, row = idx >> 4, c16 = idx & 15;
                *(uint4*)(Wl + row * SG_PITCH + c16 * 8) = *(const uint4*)(Wm + (size_t)h * 16384 + row * 128 + c16 * 8); }
            { const int r0 = 2 * lane; const f32x2 st0 = stats[r0], st1 = stats[r0 + 1];
#pragma unroll
              for (int gi = 0; gi < 4; ++gi) { const int c0 = (wave * 4 + gi) * 8, gc = h * 256 + c0; float x0[8], x1[8];
                  unpack8(*(const uint4*)(Z + (R0 + r0) * 4096 + 2048 + gc), x0); unpack8(*(const uint4*)(Z + (R0 + r0 + 1) * 4096 + 2048 + gc), x1);
                  const float4 g0 = *(const float4*)(lng + gc), g1 = *(const float4*)(lng + gc + 4), b0 = *(const float4*)(lnb + gc), b1 = *(const float4*)(lnb + gc + 4);
                  const float gg[8] = {g0.x, g0.y, g0.z, g0.w, g1.x, g1.y, g1.z, g1.w}, bb[8] = {b0.x, b0.y, b0.z, b0.w, b1.x, b1.y, b1.z, b1.w};
#pragma unroll
                  for (int j = 0; j < 8; ++j) { const float v0 = (x0[j] - st0.x) * st0.y * gg[j] + bb[j], v1 = (x1[j] - st1.x) * st1.y * gg[j] + bb[j];
                      *(unsigned*)(vT + (c0 + j) * SG_PITCH + r0) = pk2(v0, v1); } } }
            __syncthreads();
            f32x4 acc[8][2];
#pragma unroll
            for (int tb = 0; tb < 8; ++tb) { acc[tb][0] = (f32x4){0.f, 0.f, 0.f, 0.f}; acc[tb][1] = (f32x4){0.f, 0.f, 0.f, 0.f}; }
            bf16x8 vf[2][4];
#pragma unroll
            for (int cbi = 0; cbi < 2; ++cbi)
#pragma unroll
                for (int ks = 0; ks < 4; ++ks) vf[cbi][ks] = *(const bf16x8*)(vT + (wave * 32 + cbi * 16 + l15) * SG_PITCH + ks * 32 + quad * 8);
#pragma unroll
            for (int tb = 0; tb < 8; ++tb)
#pragma unroll
                for (int ks = 0; ks < 4; ++ks) if (ks <= tb / 2) { const bf16x8 wf = *(const bf16x8*)(Wl + (tb * 16 + l15) * SG_PITCH + ks * 32 + quad * 8);
                    acc[tb][0] = __builtin_amdgcn_mfma_f32_16x16x32_bf16(vf[0][ks], wf, acc[tb][0], 0, 0, 0);
                    acc[tb][1] = __builtin_amdgcn_mfma_f32_16x16x32_bf16(vf[1][ks], wf, acc[tb][1], 0, 0, 0); }
#pragma unroll
            for (int tb = 0; tb < 8; ++tb) { const int t = tb * 16 + l15; const float bias = sb[h * 128 + t];
#pragma unroll
                for (int cbi = 0; cbi < 2; ++cbi) { const int c = h * 256 + wave * 32 + cbi * 16 + quad * 4;
                    const uint2 ud = *(const uint2*)(Z + (R0 + t) * 4096 + c); const f32x4 a = acc[tb][cbi];
                    uint2 w; w.x = pk2(bflo(ud.x) * (a[0] + bias), bfhi(ud.x) * (a[1] + bias)); w.y = pk2(bflo(ud.y) * (a[2] + bias), bfhi(ud.y) * (a[3] + bias));
                    *(uint2*)(UM + (R0 + t) * 2048 + c) = w; } }
            __syncthreads();
        }
    }
}

__global__ void __launch_bounds__(512, 2) hybrid_fwd(Params P) {
    extern __shared__ __attribute__((aligned(16))) unsigned char lds[];
    cg::grid_group grid = cg::this_grid();
    PG8_LAS unsigned char* ldsg = (PG8_LAS unsigned char*)lds;
    unsigned char* ws = P.ws;
    const int G = (int)gridDim.x;
    float* R = P.out;
    bf16_t* ACTB = (bf16_t*)(ws + OFF_ACTB); bf16_t* PB = (bf16_t*)(ws + OFF_PB); bf16_t* ZB = (bf16_t*)(ws + OFF_ZBUF); bf16_t* HFB = (bf16_t*)(ws + OFF_HF);
    float* PP = (float*)(ws + OFF_ZBUF);

    prep_phase(P, (float*)lds);
    grid.sync();

    for (int layer = 0; layer < 2; ++layer) {
        const bf16_t* Ain = (layer == 0) ? ACTB : HFB;
        if (layer == 0) {
            { pg8::Gemm g{Ain, (const bf16_t*)(ws + OFF_WT_EIN), MTOK, EIN, DM}; pg8::StaticOrder S; S.init(MTOK, EIN, G, fresh_bid());
              pg8::EpiBf16<0> E{ZB, EIN, nullptr, 0, 0}; pg8::gemm_phase<pg8::EpiBf16<0>, pg8::StaticOrder>(ldsg, g, S, E, nullptr); }
            grid.sync();
            mixer0_phase(ZB, P.in[5], HFB);
            grid.sync();
            { pg8::Gemm g{HFB, (const bf16_t*)(ws + OFF_WT_EOUT), MTOK, DM, DM}; pg8::StaticOrder S; S.init(MTOK, DM, G, fresh_bid());
              pg8::EpiRes E{P.in[0], R, DM, ALPHA}; pg8::gemm_phase<pg8::EpiRes, pg8::StaticOrder>(ldsg, g, S, E, nullptr); }
        } else {
            { pg8::Gemm g{Ain, (const bf16_t*)(ws + OFF_WT_OIN), MTOK, 4096, DM}; pg8::StaticOrder S; S.init(MTOK, 4096, G, fresh_bid());
              pg8::EpiBf16<1> E{ZB, 4096, nullptr, 0, 0}; pg8::gemm_phase<pg8::EpiBf16<1>, pg8::StaticOrder>(ldsg, g, S, E, nullptr); }
            grid.sync();
            sgu_phase(lds, ZB, (const bf16_t*)(ws + OFF_SGUW), P.in[8], P.in[9], P.in[11], HFB);
            grid.sync();
            { pg8::Gemm g{HFB, (const bf16_t*)(ws + OFF_WT_OOUT), MTOK, DM, 2048}; pg8::StaticOrder S; S.init(MTOK, DM, G, fresh_bid());
              pg8::EpiRes E{R, R, DM, ALPHA}; pg8::gemm_phase<pg8::EpiRes, pg8::StaticOrder>(ldsg, g, S, E, nullptr); }
        }
        grid.sync();
        ln_phase(R, P.in[13] + layer * DM, P.in[14] + layer * DM, ACTB);
        grid.sync();
        for (int hh = 0; hh < 2; ++hh) {
            { pg8::Gemm g{ACTB + (size_t)hh * MH * DM, (const bf16_t*)(ws + OFF_WT_UP + layer * SZ_WT_UP), MH, 2 * DFF, DM}; pg8::StaticOrder S; S.init(MH, 2 * DFF, G, fresh_bid());
              pg8::EpiBf16<0> E{ZB, 2 * DFF, nullptr, 0, 0}; pg8::gemm_phase<pg8::EpiBf16<0>, pg8::StaticOrder>(ldsg, g, S, E, nullptr); }
            grid.sync();
            ffnconv_phase(ZB, P.in[16] + (size_t)layer * 3 * DFF, P.in[17] + (size_t)layer * DFF, HFB);
            grid.sync();
            { pg8::Gemm g{HFB, (const bf16_t*)(ws + OFF_WT_DOWN + layer * SZ_WT_DOWN), MH, DM, DFF}; pg8::StaticOrder S; S.init(MH, DM, G, fresh_bid());
              float* Rh = R + (size_t)hh * MH * DM; pg8::EpiRes E{Rh, Rh, DM, ALPHA}; pg8::gemm_phase<pg8::EpiRes, pg8::StaticOrder>(ldsg, g, S, E, nullptr); }
            grid.sync();
        }
        ln_phase(R, P.in[19] + layer * DM, P.in[20] + layer * DM, ACTB);
        if (layer == 1) convert_bf16(P.in[1] + (size_t)MTOK * PLE, PB, (size_t)MTOK * PLE);
        grid.sync();
        { pg8::Gemm g{PB, (const bf16_t*)(ws + OFF_WT_PROJ + layer * SZ_WT_PROJ), MTOK, DM, PLE}; pg8::StaticOrder S; S.init(MTOK, DM, G, fresh_bid());
          pg8::EpiF32 E{PP, DM, nullptr}; pg8::gemm_phase<pg8::EpiF32, pg8::StaticOrder>(ldsg, g, S, E, nullptr); }
        grid.sync();
        { pg8::Gemm g{ACTB, (const bf16_t*)(ws + OFF_WT_GATE + layer * SZ_WT_GATE), MTOK, DM, DM}; pg8::StaticOrder S; S.init(MTOK, DM, G, fresh_bid());
          pg8::EpiPle E{R, PP, P.in[22] + layer * DM, (layer == 0) ? HFB : nullptr, DM}; pg8::gemm_phase<pg8::EpiPle, pg8::StaticOrder>(ldsg, g, S, E, nullptr); }
        if (layer == 0) grid.sync();
    }
}

extern "C" void kernel_launch(void* const* d_in, const int* in_sizes, int n_in, void* d_out, int out_size, void* d_ws, size_t ws_size, hipStream_t stream) {
    static int grid_blocks = 0;
    if (grid_blocks == 0) {
        if (n_in != 24 || out_size != MTOK * DM || ws_size < WS_END) { fprintf(stderr, "kernel_launch: unexpected shapes (n_in %d out %d ws %zu need %zu)\n", n_in, out_size, ws_size, (size_t)WS_END); grid_blocks = -1; return; }
        int dev = 0, cus = 0, per_cu = 0;
        hipGetDevice(&dev); hipDeviceGetAttribute(&cus, hipDeviceAttributeMultiprocessorCount, dev);
        if (hipFuncSetAttribute((const void*)hybrid_fwd, hipFuncAttributeMaxDynamicSharedMemorySize, LDS_BYTES) != hipSuccess) { fprintf(stderr, "kernel_launch: hipFuncSetAttribute failed\n"); grid_blocks = -1; return; }
        if (hipOccupancyMaxActiveBlocksPerMultiprocessor(&per_cu, (const void*)hybrid_fwd, 512, LDS_BYTES) != hipSuccess || per_cu < 1) { fprintf(stderr, "kernel_launch: occupancy query gave %d\n", per_cu); per_cu = 1; }
        (void)hipGetLastError();
        grid_blocks = cus * 1;
    }
    if (grid_blocks < 0) return;
    Params p{};
    for (int i = 0; i < 24; ++i) p.in[i] = (const float*)d_in[i];
    p.out = (float*)d_out; p.ws = (unsigned char*)d_ws;
    void* args[] = {&p};
    hipError_t e = hipLaunchCooperativeKernel((const void*)hybrid_fwd, dim3(grid_blocks), dim3(512), args, LDS_BYTES, stream);
    if (e != hipSuccess) fprintf(stderr, "cooperative launch failed: %s (grid %d)\n", hipGetErrorString(e), grid_blocks);
}
```

```cpp
#include <hip/hip_runtime.h>
#include <hip/hip_cooperative_groups.h>
#include <cstdio>
namespace cg = cooperative_groups;
__device__ __forceinline__ int fresh_tid(int wv) { int l; asm volatile("v_mbcnt_lo_u32_b32 %0, -1, 0\n\tv_mbcnt_hi_u32_b32 %0, -1, %0" : "=v"(l)); return (wv << 6) | l; }
__device__ __forceinline__ int fresh_bid() { int b = (int)blockIdx.x; asm volatile("" : "+s"(b)); return b; }
namespace pg8 {
#define PG8_LAS __attribute__((address_space(3)))
typedef unsigned short bf16_t;
typedef short bf16x8 __attribute__((ext_vector_type(8)));
typedef float f32x4 __attribute__((ext_vector_type(4)));
typedef unsigned u32x4 __attribute__((ext_vector_type(4)));
constexpr int BM = 256, BK = 64, HALF = 128, HTB = HALF * BK * 2  , STAGE_BYTES = 8 * HTB, NXCD = 8, WGM = 8;

__host__ __device__ __forceinline__ int lds_byte(int r, int c) { const int st = (r >> 4) * 2 + (c >> 5), rr = r & 15, cc = c & 31, ob = rr * 64 + cc * 2; return st * 1024 + (ob ^ (((ob >> 9) & 1) << 5)); }
__host__ __device__ __forceinline__ void stage_rc(int b, int& R, int& C) { const int st = b / 1024, sb = b % 1024, swz = sb ^ (((sb >> 9) & 1) << 5); R = (st >> 1) * 16 + swz / 64; C = (st & 1) * 32 + (swz % 64) / 2; }
__host__ __device__ __forceinline__ int perm32(int rho) { const int n = rho >> 4, i = rho & 15; return 8 * (i >> 2) + 4 * n + (i & 3); }

struct Unit { int pm, pn; };
struct Gemm { const bf16_t* A; const bf16_t* Bt; int M, N, K; };

struct StaticOrder {
    int nM, nN, nwg, G, c;
    __host__ __device__ void init(int M, int N, int G_, int c_) { nM = M / BM; nN = N / BM; nwg = nM * nN; G = G_; c = c_; }
    __host__ __device__ bool next(int i, Unit& u) const {
        const long L = (long)i * G + c; if (L >= nwg) return false;
        int wgid = (int)L; { const int q = nwg / NXCD, r = nwg % NXCD, xcd = wgid % NXCD, off = wgid / NXCD; wgid = (xcd < r ? xcd * (q + 1) : r * (q + 1) + (xcd - r) * q) + off; }
        const int nig = WGM * nN, gid = wgid / nig, fm = gid * WGM, gsz = (nM - fm) < WGM ? (nM - fm) : WGM;
        u.pm = fm + ((wgid % nig) % gsz); u.pn = (wgid % nig) / gsz; return true;
    }
    __device__ __forceinline__ void a_ready(const Unit&) const {}
    __device__ __forceinline__ void done(const Unit&) const {}
};
__device__ __forceinline__ unsigned cvt_pk_bf16(float lo, float hi) { unsigned r; asm volatile("v_cvt_pk_bf16_f32 %0, %1, %2" : "=v"(r) : "v"(lo), "v"(hi)); return r; }
typedef float f32x2 __attribute__((ext_vector_type(2)));
__device__ __forceinline__ f32x2 gelu_pk(f32x2 v) {
    const f32x2 av = __builtin_elementwise_abs(v), d = av * 0.2316418882f + 1.0f;
    f32x2 t; t.x = __builtin_amdgcn_rcpf(d.x); t.y = __builtin_amdgcn_rcpf(d.y);
    f32x2 q = t * 0.5307027145f + (-0.7265760135f); q = q * t + 0.7107068705f; q = q * t + (-0.142248368f); q = q * t + 0.127414796f; q = q * t;
    const f32x2 s = (v * v) * (-0.72134752044f);
    f32x2 e; e.x = __builtin_amdgcn_exp2f(s.x); e.y = __builtin_amdgcn_exp2f(s.y);
    const f32x2 m = v * (q * e), r = v - m;
    f32x2 o; o.x = v.x < 0.f ? m.x : r.x; o.y = v.y < 0.f ? m.y : r.y; return o;
}

struct EpiF32 {
    static constexpr bool PERM = false, AFTER_DRAIN = false, APERM = false;
    float* C; int ldc; const float* bias;
    __device__ __forceinline__ void operator()(const f32x4 (&acc)[2][2][4][2], const Unit& u, int wr, int wc, int fr, int fq) const {
        const int row0 = u.pm * BM + wr * 64 + fr, col0 = u.pn * BM + wc * 32 + 4 * fq;
        f32x4 bv[2][2];
#pragma unroll
        for (int bj = 0; bj < 2; ++bj)
#pragma unroll
            for (int n = 0; n < 2; ++n) bv[bj][n] = bias ? *(const f32x4*)(bias + col0 + bj * HALF + n * 16) : (f32x4){0.f, 0.f, 0.f, 0.f};
#pragma unroll
        for (int ai = 0; ai < 2; ++ai)
#pragma unroll
            for (int m = 0; m < 4; ++m) { float* rowp = C + (size_t)(row0 + ai * HALF + m * 16) * ldc + col0;
#pragma unroll
                for (int bj = 0; bj < 2; ++bj)
#pragma unroll
                    for (int n = 0; n < 2; ++n) *(f32x4*)(rowp + bj * HALF + n * 16) = acc[ai][bj][m][n] + bv[bj][n]; }
    }
};
template <int ACT  > struct EpiBf16 {
    static constexpr bool PERM = true, AFTER_DRAIN = false, APERM = false;
    bf16_t* O; int ldc; const float* bias; int split_cols; size_t split_stride;
    __device__ __forceinline__ void operator()(const f32x4 (&acc)[2][2][4][2], const Unit& u, int wr, int wc, int fr, int fq) const {
        const int row0 = u.pm * BM + wr * 64 + fr; int colt = u.pn * BM; bf16_t* base = O;
        if (split_cols) { const int t = colt / split_cols; base += (size_t)t * split_stride; colt -= t * split_cols; }
        const int col0 = colt + wc * 32 + 8 * fq, bcol0 = u.pn * BM + wc * 32 + 8 * fq;
        f32x4 bv[2][2];
#pragma unroll
        for (int bj = 0; bj < 2; ++bj)
#pragma unroll
            for (int n = 0; n < 2; ++n) bv[bj][n] = bias ? *(const f32x4*)(bias + bcol0 + bj * HALF + 4 * n) : (f32x4){0.f, 0.f, 0.f, 0.f};
#pragma unroll
        for (int ai = 0; ai < 2; ++ai)
#pragma unroll
            for (int m = 0; m < 4; ++m) { bf16_t* rowp = base + (size_t)(row0 + ai * HALF + m * 16) * ldc + col0;
#pragma unroll
                for (int bj = 0; bj < 2; ++bj) { f32x4 v0 = acc[ai][bj][m][0] + bv[bj][0], v1 = acc[ai][bj][m][1] + bv[bj][1];
                    if (ACT == 1) { f32x2 a = gelu_pk((f32x2){v0[0], v0[1]}), b = gelu_pk((f32x2){v0[2], v0[3]}), c = gelu_pk((f32x2){v1[0], v1[1]}), d = gelu_pk((f32x2){v1[2], v1[3]});
                        v0 = (f32x4){a.x, a.y, b.x, b.y}; v1 = (f32x4){c.x, c.y, d.x, d.y}; }
                    if (ACT == 2) {
#pragma unroll
                        for (int j = 0; j < 4; ++j) { v0[j] = 0.5f * v0[j] * (1.0f + erff(v0[j] * 0.70710678f)); v1[j] = 0.5f * v1[j] * (1.0f + erff(v1[j] * 0.70710678f)); } }
                    u32x4 w; w.x = cvt_pk_bf16(v0[0], v0[1]); w.y = cvt_pk_bf16(v0[2], v0[3]); w.z = cvt_pk_bf16(v1[0], v1[1]); w.w = cvt_pk_bf16(v1[2], v1[3]);
                    *(u32x4*)(rowp + bj * HALF) = w; } }
    }
};
__device__ __forceinline__ void row_mu_rstd(const float* st, int row, float& mu, float& rstd) {
    const f32x4 s = *(const f32x4*)(st + (size_t)row * 8), q = *(const f32x4*)(st + (size_t)row * 8 + 4);
    mu = ((s[0] + s[1]) + (s[2] + s[3])) * (1.0f / 1024.0f); const float var = fmaxf(((q[0] + q[1]) + (q[2] + q[3])) * (1.0f / 1024.0f) - mu * mu, 0.f);
    rstd = 1.0f / sqrtf(var + 1e-5f);
}
template <bool AP> __device__ __forceinline__ void wave_row_stats(const float* st, int pm, int wr, int fr, int fq, float (&mu)[8], float (&rs)[8]) {
    const int lane = fq * 16 + fr; float ma, ra, mb, rb;
    row_mu_rstd(st, AP ? pm * BM + wr * 128 + lane : pm * BM + wr * 64 + lane, ma, ra);
    row_mu_rstd(st, AP ? pm * BM + wr * 128 + 64 + lane : pm * BM + HALF + wr * 64 + lane, mb, rb);
#pragma unroll
    for (int j = 0; j < 8; ++j) { const int src = (j & 3) * 16 + fr; mu[j] = __shfl(j < 4 ? ma : mb, src); rs[j] = __shfl(j < 4 ? ra : rb, src); }
}
template <bool LNB> struct EpiResLn {
    static constexpr bool PERM = false, AFTER_DRAIN = false, APERM = false;
    const float* base; float* out; bf16_t* outb; int ldc; const float* bst; const float* bg; const float* bb; float* ost; PG8_LAS float* xl;
    __device__ __forceinline__ void operator()(const f32x4 (&acc)[2][2][4][2], const Unit& u, int wr, int wc, int fr, int fq) const {
        typedef unsigned u32x2v __attribute__((ext_vector_type(2))); typedef float f32x2v __attribute__((ext_vector_type(2)));
        asm volatile("" : "+v"(fr), "+v"(fq));
        const int row0 = u.pm * BM + wr * 64 + fr, col0 = u.pn * BM + wc * 32 + 4 * fq, lane = fq * 16 + fr;
        const unsigned lo = (unsigned)row0 * (unsigned)ldc + (unsigned)col0;
#define ERL_OFF(j, g) ((size_t)((((j) >> 2) * HALF + ((j) & 3) * 16) * ldc + ((g) >> 1) * HALF + ((g) & 1) * 16) + lo)
        f32x4 gvv[4], bvv[4]; float ma = 0.f, ra = 1.f, mb = 0.f, rb = 1.f;
        if constexpr (LNB) {
#pragma unroll
            for (int g = 0; g < 4; ++g) { const int cc = col0 + (g >> 1) * HALF + (g & 1) * 16; gvv[g] = *(const f32x4*)(bg + cc); bvv[g] = *(const f32x4*)(bb + cc); }
            row_mu_rstd(bst, u.pm * BM + wr * 64 + lane, ma, ra); row_mu_rstd(bst, u.pm * BM + HALF + wr * 64 + lane, mb, rb); }
        constexpr int DIST = LNB ? 1 : 3, NB = DIST + 1;
        f32x4 buf[NB][4];
#pragma unroll
        for (int jp = 0; jp < DIST; ++jp)
#pragma unroll
            for (int g = 0; g < 4; ++g) buf[jp][g] = *(const f32x4*)(base + ERL_OFF(jp, g));
#pragma unroll
        for (int j = 0; j < 8; ++j) {
            if (j + DIST < 8) {
#pragma unroll
                for (int g = 0; g < 4; ++g) buf[(j + DIST) % NB][g] = *(const f32x4*)(base + ERL_OFF(j + DIST, g)); }
            float mu = 0.f, rs = 1.f; if constexpr (LNB) { const int src = (j & 3) * 16 + fr; mu = __shfl(j < 4 ? ma : mb, src); rs = __shfl(j < 4 ? ra : rb, src); }
            float s = 0.f, q = 0.f;
#pragma unroll
            for (int g = 0; g < 4; ++g) { const size_t p = ERL_OFF(j, g); f32x4 bs = buf[j % NB][g]; if constexpr (LNB) bs = (bs - mu) * rs * gvv[g] + bvv[g];
                const f32x4 o = bs * 1.41421356237f   + acc[j >> 2][g >> 1][j & 3][g & 1]; *(f32x4*)(out + p) = o;
                u32x2v w; w.x = cvt_pk_bf16(o[0], o[1]); w.y = cvt_pk_bf16(o[2], o[3]); *(u32x2v*)(outb + p) = w;
                s += (o[0] + o[1]) + (o[2] + o[3]); q += (o[0] * o[0] + o[1] * o[1]) + (o[2] * o[2] + o[3] * o[3]); }
            s += __shfl_xor(s, 16); s += __shfl_xor(s, 32); q += __shfl_xor(q, 16); q += __shfl_xor(q, 32);
            if (fq == 0) *(PG8_LAS f32x2v*)(xl + (((j >> 2) * HALF + wr * 64 + (j & 3) * 16 + fr) * 4 + wc) * 2) = (f32x2v){s, q};
            asm volatile("" ::: "memory"); }
#undef ERL_OFF
        asm volatile("s_waitcnt lgkmcnt(0)" ::: "memory"); __builtin_amdgcn_s_barrier(); asm volatile("" ::: "memory");
        const int hl = wc * 64 + lane;
        if (hl < 128) { const int rl = (hl >> 6) * HALF + wr * 64 + (hl & 63); const f32x4 a = *(const PG8_LAS f32x4*)(xl + rl * 8), b = *(const PG8_LAS f32x4*)(xl + rl * 8 + 4);
            float* sp = ost + (size_t)(u.pm * BM + rl) * 8 + u.pn; sp[0] = (a[0] + a[2]) + (b[0] + b[2]); sp[4] = (a[1] + a[3]) + (b[1] + b[3]); }
    }
};
struct EpiPle {
    static constexpr bool PERM = false, AFTER_DRAIN = false, APERM = false;
    float* R; const bf16_t* PP; const float* st; const float* csum; const float* cbias; const float* lg; const float* lb; bf16_t* xb; int ldc;
    __device__ __forceinline__ void operator()(const f32x4 (&acc)[2][2][4][2], const Unit& u, int wr, int wc, int fr, int fq) const {
        typedef unsigned u32x2v __attribute__((ext_vector_type(2)));
        asm volatile("" : "+v"(fr), "+v"(fq));
        const int row0 = u.pm * BM + wr * 64 + fr, col0 = u.pn * BM + wc * 32 + 4 * fq, lane = fq * 16 + fr;
        const unsigned lo = (unsigned)row0 * (unsigned)ldc + (unsigned)col0;
#define EPL_OFF(j, bj, n) ((size_t)((((j) >> 2) * HALF + ((j) & 3) * 16) * ldc + (bj) * HALF + (n) * 16) + lo)
        float ma, ra, mb, rb; row_mu_rstd(st, u.pm * BM + wr * 64 + lane, ma, ra); row_mu_rstd(st, u.pm * BM + HALF + wr * 64 + lane, mb, rb);
#pragma unroll
        for (int bj = 0; bj < 2; ++bj) { f32x4 cs[2], cb[2], gv[2], bv[2];
#pragma unroll
            for (int n = 0; n < 2; ++n) { const int cc = col0 + bj * HALF + n * 16; cs[n] = *(const f32x4*)(csum + cc); cb[n] = *(const f32x4*)(cbias + cc); gv[n] = *(const f32x4*)(lg + cc); bv[n] = *(const f32x4*)(lb + cc); }
            f32x4 rv[2][2]; u32x2v pv[2][2];
#pragma unroll
            for (int n = 0; n < 2; ++n) { rv[0][n] = *(const f32x4*)(R + EPL_OFF(0, bj, n)); pv[0][n] = *(const u32x2v*)(PP + EPL_OFF(0, bj, n)); }
#pragma unroll
            for (int j = 0; j < 8; ++j) {
                if (j + 1 < 8) {
#pragma unroll
                    for (int n = 0; n < 2; ++n) { rv[(j + 1) & 1][n] = *(const f32x4*)(R + EPL_OFF(j + 1, bj, n)); pv[(j + 1) & 1][n] = *(const u32x2v*)(PP + EPL_OFF(j + 1, bj, n)); } }
                const int src = (j & 3) * 16 + fr; const float mu = __shfl(j < 4 ? ma : mb, src), rs = __shfl(j < 4 ? ra : rb, src);
#pragma unroll
                for (int n = 0; n < 2; ++n) { const size_t p = EPL_OFF(j, bj, n);
                    const f32x4 a = (acc[j >> 2][bj][j & 3][n] - cs[n] * mu) * rs + cb[n]; const f32x4 x = (rv[j & 1][n] - mu) * rs * gv[n] + bv[n]; const u32x2v pq = pv[j & 1][n];
                    const f32x4 pp = (f32x4){__uint_as_float(pq.x << 16), __uint_as_float(pq.x & 0xffff0000u), __uint_as_float(pq.y << 16), __uint_as_float(pq.y & 0xffff0000u)}; f32x4 o;
#pragma unroll
                    for (int t = 0; t < 4; ++t) o[t] = x[t] + pp[t] * __builtin_amdgcn_rcpf(1.0f + __builtin_amdgcn_exp2f(a[t] * -1.44269504089f));
                    *(f32x4*)(R + p) = o;
                    if (xb) { u32x2v w; w.x = cvt_pk_bf16(o[0], o[1]); w.y = cvt_pk_bf16(o[2], o[3]); *(u32x2v*)(xb + p) = w; } }
                asm volatile("" ::: "memory"); } }
#undef EPL_OFF
    }
};
template <int CTRL> __device__ __forceinline__ float dpp_keep(float old, float src) {
    return __builtin_bit_cast(float, __builtin_amdgcn_update_dpp(__builtin_bit_cast(int, old), __builtin_bit_cast(int, src), CTRL, 0xf, 0xf, false)); }
struct EpiFfn {
    static constexpr bool PERM = true, AFTER_DRAIN = false, APERM = true;
    bf16_t* H; const float* cw; const float* cb; float* side; const float* st; const float* csum; const float* cbias; int dff;
    __device__ __forceinline__ void operator()(f32x4 (&acc)[2][2][4][2], const Unit& u, int wr, int wc, int fr, int fq) const {
        asm volatile("" : "+v"(fr), "+v"(fq));
        const int ca = u.pn * 128 + wc * 32 + 8 * fq; const int rowb = u.pm * BM + wr * 128 + fr; const int blk = u.pm * 2 + wr;
        const size_t sstride = (size_t)512 * 2 * dff;
        { f32x4 csa[2], cba[2], csg[2], cbg[2];
#pragma unroll
          for (int n = 0; n < 2; ++n) { const int cc = ca + 4 * n; csa[n] = *(const f32x4*)(csum + cc); cba[n] = *(const f32x4*)(cbias + cc); csg[n] = *(const f32x4*)(csum + dff + cc); cbg[n] = *(const f32x4*)(cbias + dff + cc); }
          float mu8[8], rs8[8]; wave_row_stats<true>(st, u.pm, wr, fr, fq, mu8, rs8);
#pragma unroll
          for (int j8 = 0; j8 < 8; ++j8) { const float mu = mu8[j8], rs = rs8[j8]; const int ai = j8 >> 2, m = j8 & 3;
#pragma unroll
              for (int n = 0; n < 2; ++n) { acc[ai][0][m][n] = (acc[ai][0][m][n] - csa[n] * mu) * rs + cba[n]; acc[ai][1][m][n] = (acc[ai][1][m][n] - csg[n] * mu) * rs + cbg[n]; }
              if (j8 & 1) asm volatile("" ::: "memory"); }
          asm volatile("" ::: "memory"); }
        f32x4 w0[2], w1[2], w2[2], bb[2];
#pragma unroll
        for (int n = 0; n < 2; ++n) { const int cc = ca + 4 * n; w0[n] = *(const f32x4*)(cw + cc); w1[n] = *(const f32x4*)(cw + dff + cc); w2[n] = *(const f32x4*)(cw + 2 * dff + cc); bb[n] = *(const f32x4*)(cb + cc); }
#pragma unroll
        for (int j8 = 0; j8 < 8; ++j8) { const int ai = j8 >> 2, m = j8 & 3; u32x4 wv;
#pragma unroll
            for (int n = 0; n < 2; ++n) { const f32x4 X = acc[ai][0][m][n], G = acc[ai][1][m][n]; f32x4 a;
#pragma unroll
                for (int e = 0; e < 4; ++e) { float o1 = 0.f, o2 = 0.f;
                    if (j8 > 0) { const float xp = acc[(j8 - 1) >> 2][0][(j8 - 1) & 3][n][e]; o1 = dpp_keep<0x121>(0.f, xp); o2 = dpp_keep<0x122>(0.f, xp); }
                    const float p1 = dpp_keep<0x111>(o1, X[e]), p2 = dpp_keep<0x112>(o2, X[e]);
                    a[e] = bb[n][e] + w2[n][e] * X[e] + w1[n][e] * p1 + w0[n][e] * p2; }
                const f32x2 g0 = gelu_pk((f32x2){a[0], a[1]}), g1 = gelu_pk((f32x2){a[2], a[3]});
                const unsigned lo = cvt_pk_bf16(g0.x * G[0], g0.y * G[1]), hi = cvt_pk_bf16(g1.x * G[2], g1.y * G[3]);
                if (n == 0) { wv.x = lo; wv.y = hi; } else { wv.z = lo; wv.w = hi; }
                if (j8 == 0 && fr < 2) { float* sp = side + ((size_t)blk * 2 + fr) * dff + ca + 4 * n; *(f32x4*)(sp + sstride) = X; *(f32x4*)(sp + 2 * sstride) = G; }
                if (j8 == 7 && fr >= 14) { float* sp = side + ((size_t)blk * 2 + (fr - 14)) * dff + ca + 4 * n; *(f32x4*)sp = X; } }
            *(u32x4*)(H + (size_t)(rowb + 16 * j8) * dff + ca) = wv; asm volatile("" ::: "memory"); }
    }
};
template <class Epi, class Sched, bool STAMP = false>
__device__ __forceinline__ void gemm_phase(PG8_LAS unsigned char* lds, const Gemm g, const Sched& S, const Epi& E, unsigned long long* stamps, int wv) {
    const int tid = fresh_tid(wv), wid = __builtin_amdgcn_readfirstlane(tid >> 6), lane = tid & 63, wr = wid >> 2, wc = wid & 3, fr = lane & 15, fq = lane >> 4;
    const int K = g.K, nt = K / BK;
    int ts_lo = 0, ts_hi = 0, nts = 0; const unsigned long long rt_entry = STAMP ? (unsigned long long)wall_clock64() : 0ull;
#define PG8_STAMP() do { if (STAMP && wid == 0 && nts < 64) { const unsigned long long _c = (unsigned long long)clock64(); \
        ts_lo = (lane == nts) ? (int)(unsigned)_c : ts_lo; ts_hi = (lane == nts) ? (int)(unsigned)(_c >> 32) : ts_hi; ++nts; } } while (0)
    PG8_STAMP();
    unsigned voffA[2], voffB[2];
#pragma unroll
    for (int i = 0; i < 2; ++i) { int R, C; stage_rc(tid * 16 + i * 8192, R, C); const int Rb = Epi::PERM ? ((R & ~31) + perm32(R & 31)) : R;
        voffA[i] = (unsigned)((Epi::APERM ? (128 * (R >> 6) + (R & 63)) : R) * K + C) * 2u; voffB[i] = (unsigned)(Rb * K + C) * 2u; }
    const size_t kstep = (size_t)(BK * 2);
    const size_t hstep = (size_t)HALF * K * 2;
    const size_t tstep = 2 * hstep; const size_t hstepA = Epi::APERM ? (size_t)64 * K * 2 : hstep;
    const unsigned ldsw = (unsigned)wid * 1024u;
    const int aoff = lds_byte(wr * 64 + fr, fq * 8), boff = lds_byte(wc * 32 + fr, fq * 8);
#define PG8_SA(b, h) (((b) * 2 + (h)) * HTB)
#define PG8_SB(b, h) ((4 + (b) * 2 + (h)) * HTB)
#define PG8_STAGE(bufoff, gbase, voff) do { _Pragma("unroll") for (int _i = 0; _i < 2; ++_i) \
        __builtin_amdgcn_global_load_lds((const unsigned*)((const char*)(gbase) + (voff)[_i]), (PG8_LAS unsigned*)(lds + (bufoff) + ldsw + _i * 8192), 16, 0, 0); } while (0)
#define PG8_LDA(dst, b, h) do { _Pragma("unroll") for (int m = 0; m < 4; ++m) _Pragma("unroll") for (int k = 0; k < 2; ++k) dst[m][k] = *(const PG8_LAS bf16x8*)(lds + PG8_SA(b, h) + aoff + m * 2048 + k * 1024); } while (0)
#define PG8_LDB(dst, b, h) do { _Pragma("unroll") for (int n = 0; n < 2; ++n) _Pragma("unroll") for (int k = 0; k < 2; ++k) dst[n][k] = *(const PG8_LAS bf16x8*)(lds + PG8_SB(b, h) + boff + n * 2048 + k * 1024); } while (0)
#define PG8_MMA(ai, bj, At, Bt) do { __builtin_amdgcn_s_setprio(1); _Pragma("unroll") for (int m = 0; m < 4; ++m) _Pragma("unroll") for (int n = 0; n < 2; ++n) _Pragma("unroll") for (int k = 0; k < 2; ++k) \
        acc[ai][bj][m][n] = __builtin_amdgcn_mfma_f32_16x16x32_bf16(Bt[n][k], At[m][k], acc[ai][bj][m][n], 0, 0, 0); __builtin_amdgcn_s_setprio(0); } while (0)
#define PG8_WAIT_V(n) asm volatile("s_waitcnt vmcnt(" #n ")" ::: "memory")
#define PG8_WAIT_L(n) asm volatile("s_waitcnt lgkmcnt(" #n ")" ::: "memory")
#define PG8_BAR __builtin_amdgcn_s_barrier()
#define PG8_SCHED __builtin_amdgcn_sched_barrier(0)
    Unit cur, nxt; int ui = 0;
    if (!S.next(0, cur)) return;
    f32x4 acc[2][2][4][2];
#pragma unroll
    for (int a = 0; a < 2; ++a)
#pragma unroll
        for (int b = 0; b < 2; ++b)
#pragma unroll
            for (int m = 0; m < 4; ++m)
#pragma unroll
                for (int n = 0; n < 2; ++n) acc[a][b][m][n] = (f32x4){0.f, 0.f, 0.f, 0.f};
    bf16x8 At[4][2], B0[2][2], B1[2][2];
    const char* cA = (const char*)g.A + (size_t)cur.pm * tstep; const char* cB = (const char*)g.Bt + (size_t)cur.pn * tstep;
    S.a_ready(cur);
    PG8_STAGE(PG8_SB(0, 0), cB, voffB); PG8_STAGE(PG8_SA(0, 0), cA, voffA); PG8_STAGE(PG8_SB(0, 1), cB + hstep, voffB); PG8_STAGE(PG8_SA(0, 1), cA + hstepA, voffA);
    if (wr == 1) PG8_BAR;
    PG8_WAIT_V(4); PG8_BAR;
    PG8_STAGE(PG8_SB(1, 0), cB + kstep, voffB); PG8_STAGE(PG8_SA(1, 0), cA + kstep, voffA); PG8_STAGE(PG8_SB(1, 1), cB + hstep + kstep, voffB);
    PG8_WAIT_V(6); PG8_BAR;
    PG8_STAMP();
    for (;;) {
        const bool has_next = S.next(ui + 1, nxt);
        const char* nA = has_next ? (const char*)g.A + (size_t)nxt.pm * tstep : cA; const char* nB = has_next ? (const char*)g.Bt + (size_t)nxt.pn * tstep : cB;
        for (int t = 0; t < nt; t += 2) {
            const bool last = (t == nt - 2);
            const char* a1 = cA + (size_t)(t + 1) * kstep;
            const char* a2 = last ? nA : cA + (size_t)(t + 2) * kstep; const char* b2 = last ? nB : cB + (size_t)(t + 2) * kstep;
            const char* a3 = a2 + kstep; const char* b3 = b2 + kstep;
            if (last && has_next) S.a_ready(nxt);
            PG8_LDB(B0, 0, 0); PG8_SCHED; PG8_LDA(At, 0, 0); PG8_STAGE(PG8_SA(1, 1), a1 + hstepA, voffA);
            PG8_WAIT_L(8); PG8_BAR; PG8_WAIT_L(0); PG8_MMA(0, 0, At, B0); PG8_BAR; PG8_SCHED;
            PG8_LDB(B1, 0, 1); PG8_STAGE(PG8_SB(0, 0), b2, voffB);
            PG8_BAR; PG8_WAIT_L(0); PG8_MMA(0, 1, At, B1); PG8_BAR;
            PG8_LDA(At, 0, 1); PG8_STAGE(PG8_SA(0, 0), a2, voffA);
            PG8_BAR; PG8_WAIT_L(0); PG8_MMA(1, 0, At, B0); PG8_BAR; PG8_SCHED;
            PG8_STAGE(PG8_SB(0, 1), b2 + hstep, voffB);
            PG8_WAIT_V(6); PG8_BAR; PG8_MMA(1, 1, At, B1); PG8_BAR;
            PG8_LDB(B0, 1, 0); PG8_SCHED; PG8_LDA(At, 1, 0); PG8_STAGE(PG8_SA(0, 1), a2 + hstepA, voffA);
            PG8_WAIT_L(8); PG8_BAR; PG8_WAIT_L(0); PG8_MMA(0, 0, At, B0); PG8_BAR; PG8_SCHED;
            PG8_LDB(B1, 1, 1); PG8_STAGE(PG8_SB(1, 0), b3, voffB);
            PG8_BAR; PG8_WAIT_L(0); PG8_MMA(0, 1, At, B1); PG8_BAR;
            PG8_LDA(At, 1, 1); PG8_STAGE(PG8_SA(1, 0), a3, voffA);
            PG8_BAR; PG8_WAIT_L(0); PG8_MMA(1, 0, At, B0); PG8_BAR; PG8_SCHED;
            PG8_STAGE(PG8_SB(1, 1), b3 + hstep, voffB);
            PG8_WAIT_V(6); PG8_BAR; PG8_MMA(1, 1, At, B1); PG8_BAR;
        }
        PG8_STAMP();
        if constexpr (!Epi::AFTER_DRAIN) { E(acc, cur, wr, wc, fr, fq); S.done(cur); }
        PG8_STAMP();
        if (!has_next) break;
#pragma unroll
        for (int a = 0; a < 2; ++a)
#pragma unroll
            for (int b = 0; b < 2; ++b)
#pragma unroll
                for (int m = 0; m < 4; ++m)
#pragma unroll
                    for (int n = 0; n < 2; ++n) acc[a][b][m][n] = (f32x4){0.f, 0.f, 0.f, 0.f};
        cur = nxt; cA = nA; cB = nB; ++ui;
    }
    PG8_WAIT_V(0);
    if (wr == 0) PG8_BAR;
    PG8_BAR;
    if constexpr (Epi::AFTER_DRAIN) { E.fused(acc, cur, wr, wc, fr, fq, lds, wid, lane); S.done(cur); }
    PG8_STAMP();
    if (STAMP && wid == 0) { stamps[lane] = lane < nts ? (((unsigned long long)(unsigned)ts_hi << 32) | (unsigned)ts_lo) : 0ull;
        if (lane == 62) stamps[62] = rt_entry; if (lane == 63) stamps[63] = (unsigned long long)wall_clock64(); }
#undef PG8_STAMP
#undef PG8_SA
#undef PG8_SB
#undef PG8_STAGE
#undef PG8_LDA
#undef PG8_LDB
#undef PG8_MMA
#undef PG8_WAIT_V
#undef PG8_WAIT_L
#undef PG8_BAR
#undef PG8_SCHED
}
}
#define XB_TMO      128
#define XB_XCNT(j)  (256  + 64 * (j))
#define XB_XSUB(j)  (1280 + 64 * (j))
#define XB_XGEN(j)  (2304 + 64 * (j))
#define XB_TOP      3328
#define XB_TOPGEN   3392
#define XCD_BAR_WORDS 3456
#define XB_SPIN_CAP (1u << 18)
#define LAS __attribute__((address_space(3)))

__device__ __forceinline__ unsigned xb_ld(unsigned* p)              { return __hip_atomic_load(p, __ATOMIC_RELAXED, __HIP_MEMORY_SCOPE_AGENT); }
__device__ __forceinline__ unsigned xb_add(unsigned* p, unsigned v) { return __hip_atomic_fetch_add(p, v, __ATOMIC_RELAXED, __HIP_MEMORY_SCOPE_AGENT); }
__device__ __forceinline__ unsigned xb_xcc_id() { return (unsigned)__builtin_amdgcn_s_getreg((3 << 11) | 20) & 0xFu; }
#define XB_SPIN(cond, bar) do { unsigned _sp = 0; while (cond) { __builtin_amdgcn_s_sleep(1); \
    if ((++_sp & 255u) == 0u) { if (xb_ld(&(bar)[XB_TMO])) break; if (_sp > XB_SPIN_CAP) { atomicAdd(&(bar)[XB_TMO], 1u); break; } } } } while (0)

struct XcdBarrier {
    unsigned* bar; unsigned x;
    volatile LAS unsigned* st;
};

__device__ __forceinline__ XcdBarrier xcd_barrier_post(unsigned* bar, volatile LAS unsigned* st, int tid) {
    XcdBarrier b; b.bar = bar; b.x = xb_xcc_id(); b.st = st;
    if (tid == 0) (void)xb_add(&bar[XB_XCNT(b.x)], 1u);
    return b;
}
__device__ __forceinline__ void xcd_barrier_complete(unsigned* bar, unsigned x, unsigned& nloc, unsigned& nx) {
    const unsigned G = gridDim.x * gridDim.y * gridDim.z;
    unsigned sum, cnt, mine, sp = 0u;
    for (;;) {
        sum = 0u; cnt = 0u; mine = 0u;
#pragma unroll
        for (unsigned j = 0; j < 16; ++j) { const unsigned c = xb_ld(&bar[XB_XCNT(j)]); sum += c; cnt += (c > 0u) ? 1u : 0u; mine = (j == x) ? c : mine; }
        if (sum == G) break;
        __builtin_amdgcn_s_sleep(1);
        if ((++sp & 255u) == 0u) { if (xb_ld(&bar[XB_TMO])) break; if (sp > XB_SPIN_CAP) { atomicAdd(&bar[XB_TMO], 1u); break; } }
    }
    nloc = mine > 0u ? mine : 1u; nx = cnt > 0u ? cnt : 1u;
}

__device__ __forceinline__ void xcd_barrier(const XcdBarrier& b, int tid) {
    asm volatile("s_waitcnt vmcnt(0)" ::: "memory");
    __syncthreads();
    if (tid == 0) {
        unsigned* bar = b.bar;
        __builtin_amdgcn_s_waitcnt(0);
        unsigned nloc = b.st[0], nx = b.st[1];
        if (nloc == 0u) { xcd_barrier_complete(bar, b.x, nloc, nx); b.st[0] = nloc; b.st[1] = nx; }
        const unsigned old = xb_add(&bar[XB_XSUB(b.x)], 1u);
        const unsigned gen = old / nloc;
        if (old + 1u == (gen + 1u) * nloc) {
            __builtin_amdgcn_fence(__ATOMIC_RELEASE, "agent");
            asm volatile("s_waitcnt vmcnt(0)" ::: "memory");
            const unsigned og = xb_add(&bar[XB_TOP], 1u);
            const unsigned tg = og / nx;
            if (og + 1u == (tg + 1u) * nx) xb_add(&bar[XB_TOPGEN], 1u);
            else XB_SPIN(xb_ld(&bar[XB_TOPGEN]) == tg, bar);
            __builtin_amdgcn_fence(__ATOMIC_ACQUIRE, "agent");
            xb_add(&bar[XB_XGEN(b.x)], 1u);
            asm volatile("s_waitcnt vmcnt(0)" ::: "memory");
        } else {
            XB_SPIN(xb_ld(&bar[XB_XGEN(b.x)]) == gen, bar);
            __builtin_amdgcn_fence(__ATOMIC_ACQUIRE, "agent");
            asm volatile("s_waitcnt vmcnt(0)" ::: "memory");
        }
    }
    __syncthreads();
}

typedef pg8::bf16_t bf16_t;
typedef pg8::bf16x8 bf16x8;
typedef pg8::f32x4 f32x4;
typedef float f32x2 __attribute__((ext_vector_type(2)));
constexpr int MTOK = 65536, DM = 1024, SEQL = 4096, EIN = 2048, DFF = 2816, SGUW_ = 2048, PLE = 256;
constexpr float ALPHA = 1.41421356237f, LNEPS = 1e-5f;
constexpr int XL_OFF = pg8::STAGE_BYTES + 256;
constexpr int LDS_BYTES = pg8::STAGE_BYTES + 256 + 8192;

constexpr size_t al256(size_t x) { return (x + 255) & ~(size_t)255; }
constexpr size_t OFF_WT_EIN = 0;
constexpr size_t OFF_WT_EOUT = OFF_WT_EIN + (size_t)EIN * DM * 2;
constexpr size_t OFF_WT_OIN = OFF_WT_EOUT + (size_t)DM * DM * 2;
constexpr size_t OFF_WT_OOUT = OFF_WT_OIN + (size_t)4096 * DM * 2;
constexpr size_t OFF_WT_UP = OFF_WT_OOUT + (size_t)DM * 2048 * 2;
constexpr size_t SZ_WT_UP = (size_t)2 * DFF * DM * 2;
constexpr size_t OFF_WT_DOWN = OFF_WT_UP + 2 * SZ_WT_UP;
constexpr size_t SZ_WT_DOWN = (size_t)DM * DFF * 2;
constexpr size_t OFF_WT_GATE = OFF_WT_DOWN + 2 * SZ_WT_DOWN;
constexpr size_t SZ_WT_GATE = (size_t)DM * DM * 2;
constexpr size_t OFF_WT_PROJ = OFF_WT_GATE + 2 * SZ_WT_GATE;
constexpr size_t SZ_WT_PROJ = (size_t)DM * PLE * 2;
constexpr size_t OFF_SGUW = OFF_WT_PROJ + 2 * SZ_WT_PROJ;
constexpr size_t OFF_ACTB = al256(OFF_SGUW + (size_t)8 * 128 * 128 * 2);
constexpr size_t OFF_PB = OFF_ACTB + (size_t)MTOK * DM * 2;
constexpr size_t OFF_ZBUF = OFF_PB + (size_t)2 * MTOK * PLE * 2;
constexpr size_t OFF_HF = OFF_ZBUF + (size_t)MTOK * 4096 * 2;
constexpr size_t OFF_BAR = OFF_HF + (size_t)MTOK * 2048 * 2;
constexpr size_t OFF_ST = al256(OFF_BAR + (size_t)XCD_BAR_WORDS * 4);
constexpr size_t SZ_ST = (size_t)MTOK * 8 * 4;
constexpr size_t OFF_CS = OFF_ST + 2 * SZ_ST;
constexpr size_t SZ_CS = (size_t)(2 * 2 * DFF + 2 * DM) * 4 * 2;
constexpr size_t WS_END = OFF_CS + 2 * SZ_CS;

struct Params { const float* in[24]; float* out; unsigned char* ws; };

__device__ __forceinline__ unsigned pk2(float lo, float hi) { return pg8::cvt_pk_bf16(lo, hi); }
__device__ __forceinline__ float bflo(unsigned u) { return __uint_as_float(u << 16); }
__device__ __forceinline__ float bfhi(unsigned u) { return __uint_as_float(u & 0xffff0000u); }
__device__ __forceinline__ unsigned short f2bf(float f) { unsigned u = __float_as_uint(f); u += 0x7FFFu + ((u >> 16) & 1u); return (unsigned short)(u >> 16); }
__device__ __forceinline__ void unpack8(const uint4 d, float (&f)[8]) {
    f[0] = bflo(d.x); f[1] = bfhi(d.x); f[2] = bflo(d.y); f[3] = bfhi(d.y); f[4] = bflo(d.z); f[5] = bfhi(d.z); f[6] = bflo(d.w); f[7] = bfhi(d.w); }
__device__ __forceinline__ uint4 pack8(const float (&f)[8]) { uint4 o; o.x = pk2(f[0], f[1]); o.y = pk2(f[2], f[3]); o.z = pk2(f[4], f[5]); o.w = pk2(f[6], f[7]); return o; }

template <bool UPMAP = false> __device__ __forceinline__ void transpose_w(float* tile, const float* __restrict__ src, int lds_, bf16_t* __restrict__ dst, int ldd, int K, int N, int wv) {
    const int tid = fresh_tid(wv); const int tn = N / 64, nt = (K / 128) * tn;
    for (int tix = fresh_bid(); tix < nt; tix += gridDim.x) {
        const int k0 = (tix / tn) * 128, n0 = (tix % tn) * 64; float4 v[4];
#pragma unroll
        for (int p = 0; p < 4; ++p) v[p] = *(const float4*)(src + (size_t)(k0 + (tid >> 4) + p * 32) * lds_ + n0 + (tid & 15) * 4);
#pragma unroll
        for (int p = 0; p < 4; ++p) { float* t = tile + ((tid >> 4) + p * 32) * 65 + (tid & 15) * 4; t[0] = v[p].x; t[1] = v[p].y; t[2] = v[p].z; t[3] = v[p].w; }
        __syncthreads();
        { const int nn = tid >> 3, k16 = (tid & 7) * 16; float f[8], h[8];
#pragma unroll
          for (int j = 0; j < 8; ++j) { f[j] = tile[(k16 + j) * 65 + nn]; h[j] = tile[(k16 + 8 + j) * 65 + nn]; }
          const int d0 = UPMAP ? (n0 < DFF ? 256 * (n0 >> 7) + (n0 & 127) : 256 * ((n0 - DFF) >> 7) + 128 + ((n0 - DFF) & 127)) : n0;
          bf16_t* dp = dst + (size_t)(d0 + nn) * ldd + k0 + k16; *(uint4*)dp = pack8(f); *(uint4*)(dp + 8) = pack8(h); }
        __syncthreads();
    }
}
template <bool UPMAP> __device__ __forceinline__ void transpose_fold_strip(float* tile, const float* __restrict__ src, int lds_, bf16_t* __restrict__ dst, int K, int strip,
                                                                            const float* __restrict__ g, const float* __restrict__ b, const float* __restrict__ extra, float* __restrict__ csum, float* __restrict__ cbias, int wv) {
    const int tid = fresh_tid(wv), n0 = strip * 64, nn = tid >> 3, k8 = (tid & 7) * 8; float rsum = 0.f, bsum = 0.f;
    const int d0 = UPMAP ? (n0 < DFF ? 256 * (n0 >> 7) + (n0 & 127) : 256 * ((n0 - DFF) >> 7) + 128 + ((n0 - DFF) & 127)) : n0;
    for (int k0 = 0; k0 < K; k0 += 64) {
#pragma unroll
        for (int p = 0; p < 2; ++p) { const int kk = (tid >> 4) + p * 32, n4 = (tid & 15) * 4;
            const float4 v = *(const float4*)(src + (size_t)(k0 + kk) * lds_ + n0 + n4);
            float* t = tile + kk * 65 + n4; t[0] = v.x; t[1] = v.y; t[2] = v.z; t[3] = v.w; }
        __syncthreads();
        { float f[8]; const float4 g0 = *(const float4*)(g + k0 + k8), g1 = *(const float4*)(g + k0 + k8 + 4), b0 = *(const float4*)(b + k0 + k8), b1 = *(const float4*)(b + k0 + k8 + 4);
          const float gk[8] = {g0.x, g0.y, g0.z, g0.w, g1.x, g1.y, g1.z, g1.w}, bk[8] = {b0.x, b0.y, b0.z, b0.w, b1.x, b1.y, b1.z, b1.w};
#pragma unroll
          for (int j = 0; j < 8; ++j) { const float v = tile[(k8 + j) * 65 + nn]; f[j] = gk[j] * v; bsum += bk[j] * v; }
          const uint4 o = pack8(f); float r[8]; unpack8(o, r);
#pragma unroll
          for (int j = 0; j < 8; ++j) rsum += r[j];
          *(uint4*)(dst + (size_t)(d0 + nn) * K + k0 + k8) = o; }
        __syncthreads();
    }
    rsum += __shfl_xor(rsum, 1); rsum += __shfl_xor(rsum, 2); rsum += __shfl_xor(rsum, 4);
    bsum += __shfl_xor(bsum, 1); bsum += __shfl_xor(bsum, 2); bsum += __shfl_xor(bsum, 4);
    if ((tid & 7) == 0) { csum[n0 + nn] = rsum; cbias[n0 + nn] = bsum + (extra ? extra[n0 + nn] : 0.f); }
}
__device__ __forceinline__ void convert_bf16(const float* __restrict__ src, bf16_t* __restrict__ dst, size_t n, int wv) {
    const size_t n8 = n / 8, stride = (size_t)gridDim.x * 512;
    for (size_t i = (size_t)fresh_bid() * 512 + fresh_tid(wv); i < n8; i += 4 * stride) {
        float4 a[4], b[4];
#pragma unroll
        for (int u = 0; u < 4; ++u) { const size_t ii = i + u * stride; if (ii < n8) { a[u] = *(const float4*)(src + ii * 8); b[u] = *(const float4*)(src + ii * 8 + 4); } }
#pragma unroll
        for (int u = 0; u < 4; ++u) { const size_t ii = i + u * stride; if (ii < n8) { uint4 o; o.x = pk2(a[u].x, a[u].y); o.y = pk2(a[u].z, a[u].w); o.z = pk2(b[u].x, b[u].y); o.w = pk2(b[u].z, b[u].w); *(uint4*)(dst + ii * 8) = o; } }
    }
}

template <class PP_> __device__ __forceinline__ void prep_phase(PP_ Pp, float* tile, int wv) {
#define P (*Pp)
    unsigned char* ws = P.ws;
    const int par = fresh_bid() & 1;
    for (int stg = 0; stg < 2; ++stg) { if ((stg ^ par) == 0) {
    transpose_w(tile, P.in[2], EIN, (bf16_t*)(ws + OFF_WT_EIN), DM, DM, EIN, wv);
    transpose_w(tile, P.in[6] + (size_t)512 * DM, DM, (bf16_t*)(ws + OFF_WT_EOUT) + 512, DM, 512, DM, wv);
    transpose_w(tile, P.in[7], 4096, (bf16_t*)(ws + OFF_WT_OIN), DM, DM, 4096, wv);
    transpose_w(tile, P.in[12], DM, (bf16_t*)(ws + OFF_WT_OOUT), 2048, 2048, DM, wv);
    for (int l = 0; l < 2; ++l) {
        transpose_w(tile, P.in[18] + (size_t)l * DFF * DM, DM, (bf16_t*)(ws + OFF_WT_DOWN + l * SZ_WT_DOWN), DFF, DFF, DM, wv);
        transpose_w(tile, P.in[23] + (size_t)l * PLE * DM, DM, (bf16_t*)(ws + OFF_WT_PROJ + l * SZ_WT_PROJ), PLE, PLE, DM, wv);
    }
    for (int job = fresh_bid(); job < 208; job += gridDim.x) {
        if (job < 176) { const int l = job / 88, strip = job % 88; float* cs = (float*)(ws + OFF_CS + l * SZ_CS);
            transpose_fold_strip<true>(tile, P.in[15] + (size_t)l * DM * 2 * DFF, 2 * DFF, (bf16_t*)(ws + OFF_WT_UP + l * SZ_WT_UP), DM, strip, P.in[13] + l * DM, P.in[14] + l * DM, nullptr, cs, cs + 2 * DFF, wv); }
        else { const int l = (job - 176) / 16, strip = (job - 176) % 16; float* cs = (float*)(ws + OFF_CS + l * SZ_CS) + 4 * DFF;
            transpose_fold_strip<false>(tile, P.in[21] + (size_t)l * DM * DM, DM, (bf16_t*)(ws + OFF_WT_GATE + l * SZ_WT_GATE), DM, strip, P.in[19] + l * DM, P.in[20] + l * DM, P.in[22] + l * DM, cs, cs + DM, wv); }
    }
    const size_t gt = (size_t)fresh_bid() * 512 + fresh_tid(wv), gs = (size_t)gridDim.x * blockDim.x;
    { const float* mix = P.in[3]; const float* sc = P.in[4]; const float* wo = P.in[6]; bf16_t* dst = (bf16_t*)(ws + OFF_WT_EOUT);
      for (size_t it = gt; it < (size_t)512 * DM; it += gs) { const int k = (int)(it >> 10), n = (int)(it & 1023), g = k >> 7;
          const float* mrow = mix + (size_t)k * 128; const float* srow = sc + g * 128; const float* wcol = wo + (size_t)(g * 128) * DM + n; float s = 0.f;
          for (int d = 0; d < 128; ++d) s += mrow[d] * srow[d] * wcol[(size_t)d * DM];
          dst[(size_t)n * DM + k] = f2bf(s); } }
    { const float* w = P.in[10]; bf16_t* dst = (bf16_t*)(ws + OFF_SGUW);
      for (size_t it = gt; it < (size_t)8 * 128 * 128; it += gs) { const int t = (int)((it >> 7) & 127), s = (int)(it & 127); dst[it] = (s <= t) ? f2bf(w[it]) : (bf16_t)0; } }
    } else {
    convert_bf16(P.in[0], (bf16_t*)(ws + OFF_ACTB), (size_t)MTOK * DM, wv);
    convert_bf16(P.in[1], (bf16_t*)(ws + OFF_PB), (size_t)2 * MTOK * PLE, wv);
    } }
}

#undef P
__device__ __forceinline__ void add8(float (&s)[8], const uint4 d, float sign) { float f[8]; unpack8(d, f);
#pragma unroll
    for (int j = 0; j < 8; ++j) s[j] += sign * f[j]; }
template <int W> __device__ __forceinline__ void pool_block(const bf16_t* __restrict__ Z, bf16_t* __restrict__ O, int r0, int c0) {
    const int t0 = r0 & (SEQL - 1);
    uint4 hist[W - 1], cur[8]; const uint4 z4 = make_uint4(0u, 0u, 0u, 0u);
#pragma unroll
    for (int j = 0; j < W - 1; ++j) hist[j] = (t0 - (W - 1) + j >= 0) ? *(const uint4*)(Z + (size_t)(r0 - (W - 1) + j) * EIN + c0) : z4;
#pragma unroll
    for (int i = 0; i < 8; ++i) cur[i] = *(const uint4*)(Z + (size_t)(r0 + i) * EIN + c0);
    float s[8];
#pragma unroll
    for (int j = 0; j < 8; ++j) s[j] = 0.f;
#pragma unroll
    for (int j = 0; j < W - 1; ++j) add8(s, hist[j], 1.f);
#pragma unroll
    for (int i = 0; i < 8; ++i) {
        add8(s, cur[i], 1.f);
        if (i >= 1) { if (i - W >= 0) add8(s, cur[i - W >= 0 ? i - W : 0], -1.f); else add8(s, hist[i - 1 >= 0 ? i - 1 : 0], -1.f); }
        const int cnt = (t0 + i + 1 < W) ? t0 + i + 1 : W; const float inv = 1.0f / (float)cnt; float x[8], o[8]; unpack8(cur[i], x);
#pragma unroll
        for (int j = 0; j < 8; ++j) o[j] = s[j] * inv - x[j];
        *(uint4*)(O + (size_t)(r0 + i) * DM + c0) = pack8(o);
    }
}
__device__ __forceinline__ void conv_block(const bf16_t* __restrict__ Z, const float* __restrict__ cw, bf16_t* __restrict__ O, int r0, int c0) {
    const bool hv = (r0 & (SEQL - 1)) != 0; const uint4 z4 = make_uint4(0u, 0u, 0u, 0u);
    uint4 cg[10], vv[10], bg[8];
#pragma unroll
    for (int j = 0; j < 10; ++j) { const bool ok = hv || j >= 2; const size_t ro = (size_t)(r0 - 2 + j) * EIN;
        cg[j] = ok ? *(const uint4*)(Z + ro + 1024 + c0) : z4; vv[j] = ok ? *(const uint4*)(Z + ro + 1536 + c0) : z4; }
#pragma unroll
    for (int i = 0; i < 8; ++i) bg[i] = *(const uint4*)(Z + (size_t)(r0 + i) * EIN + 512 + c0);
    float w[3][8];
#pragma unroll
    for (int k = 0; k < 3; ++k) { const float4 a = *(const float4*)(cw + k * 512 + c0), b = *(const float4*)(cw + k * 512 + c0 + 4);
        w[k][0] = a.x; w[k][1] = a.y; w[k][2] = a.z; w[k][3] = a.w; w[k][4] = b.x; w[k][5] = b.y; w[k][6] = b.z; w[k][7] = b.w; }
    float p2[8], p1[8];
    { float a[8], b[8]; unpack8(cg[0], a); unpack8(vv[0], b);
#pragma unroll
      for (int j = 0; j < 8; ++j) p2[j] = a[j] * b[j];
      unpack8(cg[1], a); unpack8(vv[1], b);
#pragma unroll
      for (int j = 0; j < 8; ++j) p1[j] = a[j] * b[j]; }
#pragma unroll
    for (int i = 0; i < 8; ++i) { float a[8], b[8], g[8], o[8]; unpack8(cg[i + 2], a); unpack8(vv[i + 2], b); unpack8(bg[i], g);
#pragma unroll
        for (int j = 0; j < 8; ++j) { const float p0 = a[j] * b[j]; o[j] = g[j] * (w[0][j] * p2[j] + w[1][j] * p1[j] + w[2][j] * p0); p2[j] = p1[j]; p1[j] = p0; }
        *(uint4*)(O + (size_t)(r0 + i) * DM + 512 + c0) = pack8(o); }
}
__device__ __forceinline__ void mixer0_phase(const bf16_t* __restrict__ Z, const float* __restrict__ cw, bf16_t* __restrict__ O, int wv) {
    const int tid = fresh_tid(wv), lane = tid & 63; const int nwaves = (int)gridDim.x * 8;
    for (int wi = fresh_bid() * 8 + wv; wi < 16384; wi += nwaves) {
        if (wi < 8192) { const int g = wi & 3, r0 = ((wi >> 2) * 4 + (lane >> 4)) * 8, c0 = g * 128 + (lane & 15) * 8;
            if (g == 0) pool_block<2>(Z, O, r0, c0); else if (g == 1) pool_block<4>(Z, O, r0, c0); else if (g == 2) pool_block<8>(Z, O, r0, c0); else pool_block<16>(Z, O, r0, c0); }
        else conv_block(Z, cw, O, (wi - 8192) * 8, lane * 8);
    }
}

__device__ __forceinline__ void ffn_fixup_phase(const float* __restrict__ side, const float* __restrict__ cw, const float* __restrict__ cb, bf16_t* __restrict__ H, int wv) {
    const size_t plane = (size_t)512 * 2 * DFF; const float* AT = side; const float* AH = side + plane; const float* GH = side + 2 * plane;
    const int total = 512 * 2 * (DFF / 4);
    for (int it = fresh_bid() * 512 + fresh_tid(wv); it < total; it += (int)gridDim.x * 512) {
        const int c = (it % (DFF / 4)) * 4, rr = (it / (DFF / 4)) & 1, blk = it / (2 * (DFF / 4)); const bool first = (blk & 31) == 0;
        const f32x4 z4 = (f32x4){0.f, 0.f, 0.f, 0.f};
        const f32x4 xh = *(const f32x4*)(AH + ((size_t)blk * 2 + rr) * DFF + c);
        const f32x4 t1 = first ? z4 : *(const f32x4*)(AT + ((size_t)(blk - 1) * 2 + 1) * DFF + c);
        const f32x4 t0 = first ? z4 : *(const f32x4*)(AT + ((size_t)(blk - 1) * 2 + 0) * DFF + c);
        const f32x4 h0 = *(const f32x4*)(AH + ((size_t)blk * 2 + 0) * DFF + c);
        const f32x4 x1 = rr ? h0 : t1, x2 = rr ? t1 : t0;
        const f32x4 w0 = *(const f32x4*)(cw + c), w1 = *(const f32x4*)(cw + DFF + c), w2 = *(const f32x4*)(cw + 2 * DFF + c), bb = *(const f32x4*)(cb + c);
        const f32x4 a = bb + w2 * xh + w1 * x1 + w0 * x2; const f32x4 g = *(const f32x4*)(GH + ((size_t)blk * 2 + rr) * DFF + c);
        const f32x2 g0 = pg8::gelu_pk((f32x2){a[0], a[1]}), g1 = pg8::gelu_pk((f32x2){a[2], a[3]});
        uint2 w; w.x = pk2(g0.x * g[0], g0.y * g[1]); w.y = pk2(g1.x * g[2], g1.y * g[3]);
        *(uint2*)(H + ((size_t)blk * 128 + rr) * DFF + c) = w;
    }
}

constexpr int SG_PITCH = 136;
__device__ __forceinline__ void sgu_phase(unsigned char* lds, const bf16_t* __restrict__ Z, const bf16_t* __restrict__ Wm, const float* __restrict__ lng, const float* __restrict__ lnb,
                                          const float* __restrict__ sb, bf16_t* __restrict__ UM, int wv) {
    const int tid = fresh_tid(wv), lane = tid & 63, wave = tid >> 6, l15 = lane & 15, quad = lane >> 4;
    f32x2* stats = (f32x2*)lds;
    bf16_t* Wl = (bf16_t*)(lds + 1024);
    bf16_t* vT = (bf16_t*)(lds + 1024 + 128 * SG_PITCH * 2);
    for (int ch = fresh_bid(); ch < MTOK / 128; ch += gridDim.x) {
        const size_t R0 = (size_t)ch * 128;
#pragma unroll 4
        for (int i = 0; i < 16; ++i) { const int row = wave * 16 + i; const bf16_t* vp = Z + (R0 + row) * 4096 + 2048; float s = 0.f, ss = 0.f;
#pragma unroll
            for (int q = 0; q < 4; ++q) { float f[8]; unpack8(*(const uint4*)(vp + q * 512 + lane * 8), f);
#pragma unroll
                for (int j = 0; j < 8; ++j) { s += f[j]; ss += f[j] * f[j]; } }
#pragma unroll
            for (int o = 32; o >= 1; o >>= 1) { s += __shfl_xor(s, o); ss += __shfl_xor(ss, o); }
            const float mean = s * (1.0f / 2048.0f), var = fmaxf(ss * (1.0f / 2048.0f) - mean * mean, 0.f);
            if (lane == 0) stats[row] = (f32x2){mean, 1.0f / sqrtf(var + LNEPS)}; }
        __syncthreads();
        const int r0 = 2 * lane; pg8::u32x4 wreg[4]; uint4 va[4], vb[4];
#define SGU_LOAD_HEAD(hh) do { _Pragma("unroll") for (int i = 0; i < 4; ++i) { const int idx = tid + i * 512; wreg[i] = *(const pg8::u32x4*)(Wm + (size_t)(hh) * 16384 + (idx >> 4) * 128 + (idx & 15) * 8); } \
            _Pragma("unroll") for (int gi = 0; gi < 4; ++gi) { const int gc = (hh) * 256 + (wave * 4 + gi) * 8; va[gi] = *(const uint4*)(Z + (R0 + r0) * 4096 + 2048 + gc); vb[gi] = *(const uint4*)(Z + (R0 + r0 + 1) * 4096 + 2048 + gc); } } while (0)
        SGU_LOAD_HEAD(0);
        for (int h = 0; h < 8; ++h) {
#pragma unroll
            for (int i = 0; i < 4; ++i) { const int idx = tid + i * 512; *(pg8::u32x4*)(Wl + (idx >> 4) * SG_PITCH + (idx & 15) * 8) = wreg[i]; }
            { const f32x2 st0 = stats[r0], st1 = stats[r0 + 1];
#pragma unroll
              for (int gi = 0; gi < 4; ++gi) { const int c0 = (wave * 4 + gi) * 8, gc = h * 256 + c0; float x0[8], x1[8]; unpack8(va[gi], x0); unpack8(vb[gi], x1);
                  const float4 g0 = *(const float4*)(lng + gc), g1 = *(const float4*)(lng + gc + 4), b0 = *(const float4*)(lnb + gc), b1 = *(const float4*)(lnb + gc + 4);
                  const float gg[8] = {g0.x, g0.y, g0.z, g0.w, g1.x, g1.y, g1.z, g1.w}, bb[8] = {b0.x, b0.y, b0.z, b0.w, b1.x, b1.y, b1.z, b1.w};
#pragma unroll
                  for (int j = 0; j < 8; ++j) { const float v0 = (x0[j] - st0.x) * st0.y * gg[j] + bb[j], v1 = (x1[j] - st1.x) * st1.y * gg[j] + bb[j];
                      *(unsigned*)(vT + (c0 + j) * SG_PITCH + r0) = pk2(v0, v1); } } }
            __syncthreads();
            uint2 ud[4][2];
#pragma unroll
            for (int tb = 0; tb < 4; ++tb)
#pragma unroll
                for (int cbi = 0; cbi < 2; ++cbi) ud[tb][cbi] = *(const uint2*)(Z + (R0 + tb * 16 + l15) * 4096 + h * 256 + wave * 32 + cbi * 16 + quad * 4);
            if (h < 7) SGU_LOAD_HEAD(h + 1);
            f32x4 acc[8][2];
#pragma unroll
            for (int tb = 0; tb < 8; ++tb) { acc[tb][0] = (f32x4){0.f, 0.f, 0.f, 0.f}; acc[tb][1] = (f32x4){0.f, 0.f, 0.f, 0.f}; }
            bf16x8 vf[2][4];
#pragma unroll
            for (int cbi = 0; cbi < 2; ++cbi)
#pragma unroll
                for (int ks = 0; ks < 4; ++ks) vf[cbi][ks] = *(const bf16x8*)(vT + (wave * 32 + cbi * 16 + l15) * SG_PITCH + ks * 32 + quad * 8);
#pragma unroll
            for (int tb = 0; tb < 8; ++tb)
#pragma unroll
                for (int ks = 0; ks < 4; ++ks) if (ks <= tb / 2) { const bf16x8 wf = *(const bf16x8*)(Wl + (tb * 16 + l15) * SG_PITCH + ks * 32 + quad * 8);
                    acc[tb][0] = __builtin_amdgcn_mfma_f32_16x16x32_bf16(vf[0][ks], wf, acc[tb][0], 0, 0, 0);
                    acc[tb][1] = __builtin_amdgcn_mfma_f32_16x16x32_bf16(vf[1][ks], wf, acc[tb][1], 0, 0, 0); }
#pragma unroll
            for (int tb = 0; tb < 8; ++tb) { const int t = tb * 16 + l15; const float bias = sb[h * 128 + t];
#pragma unroll
                for (int cbi = 0; cbi < 2; ++cbi) { const int c = h * 256 + wave * 32 + cbi * 16 + quad * 4; const uint2 u2 = (tb < 4) ? ud[tb < 4 ? tb : 0][cbi] : *(const uint2*)(Z + (R0 + t) * 4096 + c); const f32x4 a = acc[tb][cbi];
                    uint2 w; w.x = pk2(bflo(u2.x) * (a[0] + bias), bfhi(u2.x) * (a[1] + bias)); w.y = pk2(bflo(u2.y) * (a[2] + bias), bfhi(u2.y) * (a[3] + bias));
                    *(uint2*)(UM + (R0 + t) * 2048 + c) = w; } }
            __syncthreads();
        }
    }
}

__device__ __forceinline__ void stagger(int ticks) {
    if (ticks > 0 && (fresh_bid() & 7) >= 4) { const unsigned long long t0 = __builtin_amdgcn_s_memrealtime();
        while (__builtin_amdgcn_s_memrealtime() - t0 < (unsigned long long)ticks) __builtin_amdgcn_s_sleep(32); }
}
#ifndef STAG_F32
#define STAG_F32 0
#endif
#ifndef STAG_B16
#define STAG_B16 0
#endif
typedef const __attribute__((address_space(4))) Params* KParamsPtr;
__device__ __forceinline__ KParamsPtr kparams() { KParamsPtr p = (KParamsPtr)__builtin_amdgcn_kernarg_segment_ptr(); asm volatile("" : "+s"(p)); return p; }
#define P (*kparams())
__global__ void __launch_bounds__(512, 2) hybrid_fwd(Params P_unused) {
    extern __shared__ __attribute__((aligned(16))) unsigned char lds[];
    cg::grid_group grid = cg::this_grid();
    PG8_LAS unsigned char* ldsg = (PG8_LAS unsigned char*)lds;
#define ws (P.ws)
#define R (P.out)
    const int G = (int)gridDim.x; const int wv = __builtin_amdgcn_readfirstlane((int)threadIdx.x >> 6);
#define ACTB ((bf16_t*)(ws + OFF_ACTB))
#define PB ((bf16_t*)(ws + OFF_PB))
#define ZB ((bf16_t*)(ws + OFF_ZBUF))
#define HFB ((bf16_t*)(ws + OFF_HF))
#define PPB ((bf16_t*)(ws + OFF_ZBUF))

#define barw ((unsigned*)(ws + OFF_BAR))
    { const int t0 = fresh_tid(wv); if (blockIdx.x == 0) { unsigned* bw = barw; for (int i = t0; i < XCD_BAR_WORDS; i += 512) bw[i] = 0u; }
      if (t0 < 4) ((volatile LAS unsigned*)(ldsg + pg8::STAGE_BYTES))[t0] = 0u; }
    prep_phase(kparams(), (float*)lds, wv);
    grid.sync();
    (void)xcd_barrier_post(barw, (volatile LAS unsigned*)(ldsg + pg8::STAGE_BYTES), fresh_tid(wv));
#define GSYNC() do { XcdBarrier xb_; xb_.bar = barw; xb_.x = xb_xcc_id(); xb_.st = (volatile LAS unsigned*)(ldsg + pg8::STAGE_BYTES); xcd_barrier(xb_, fresh_tid(wv)); } while (0)

#define ST1 ((float*)(ws + OFF_ST))
#define ST2 ((float*)(ws + OFF_ST + SZ_ST))
#define xl ((PG8_LAS float*)(ldsg + XL_OFF))
    for (int layer = 0; layer < 2; ++layer) {
#define CS ((const float*)(ws + OFF_CS + layer * SZ_CS))
#define g1 (P.in[13] + layer * DM)
#define b1 (P.in[14] + layer * DM)
#define g2 (P.in[19] + layer * DM)
#define b2 (P.in[20] + layer * DM)
        if (layer == 0) {
            { stagger(STAG_B16); pg8::Gemm g{ACTB, (const bf16_t*)(ws + OFF_WT_EIN), MTOK, EIN, DM}; pg8::StaticOrder S; S.init(MTOK, EIN, G, fresh_bid());
              pg8::EpiBf16<0> E{ZB, EIN, nullptr, 0, 0}; pg8::gemm_phase<pg8::EpiBf16<0>, pg8::StaticOrder>(ldsg, g, S, E, nullptr, wv); }
            GSYNC();
            mixer0_phase(ZB, P.in[5], HFB, wv);
            GSYNC();
            { stagger(STAG_F32); pg8::Gemm g{HFB, (const bf16_t*)(ws + OFF_WT_EOUT), MTOK, DM, DM}; pg8::StaticOrder S; S.init(MTOK, DM, G, fresh_bid());
              pg8::EpiResLn<false> E{P.in[0], R, ACTB, DM, nullptr, nullptr, nullptr, ST1, xl}; pg8::gemm_phase<pg8::EpiResLn<false>, pg8::StaticOrder>(ldsg, g, S, E, nullptr, wv); }
        } else {
            { stagger(STAG_B16); pg8::Gemm g{HFB, (const bf16_t*)(ws + OFF_WT_OIN), MTOK, 4096, DM}; pg8::StaticOrder S; S.init(MTOK, 4096, G, fresh_bid());
              pg8::EpiBf16<1> E{ZB, 4096, nullptr, 0, 0}; pg8::gemm_phase<pg8::EpiBf16<1>, pg8::StaticOrder>(ldsg, g, S, E, nullptr, wv); }
            GSYNC();
            sgu_phase(lds, ZB, (const bf16_t*)(ws + OFF_SGUW), P.in[8], P.in[9], P.in[11], HFB, wv);
            GSYNC();
            { stagger(STAG_F32); pg8::Gemm g{HFB, (const bf16_t*)(ws + OFF_WT_OOUT), MTOK, DM, 2048}; pg8::StaticOrder S; S.init(MTOK, DM, G, fresh_bid());
              pg8::EpiResLn<false> E{R, R, ACTB, DM, nullptr, nullptr, nullptr, ST1, xl}; pg8::gemm_phase<pg8::EpiResLn<false>, pg8::StaticOrder>(ldsg, g, S, E, nullptr, wv); }
        }
        GSYNC();
        { const float* cw = P.in[16] + (size_t)layer * 3 * DFF; const float* cb = P.in[17] + (size_t)layer * DFF; float* side = (float*)(ws + OFF_HF);
          { stagger(STAG_B16); pg8::Gemm g{ACTB, (const bf16_t*)(ws + OFF_WT_UP + layer * SZ_WT_UP), MTOK, 2 * DFF, DM}; pg8::StaticOrder S; S.init(MTOK, 2 * DFF, G, fresh_bid());
            pg8::EpiFfn E{ZB, cw, cb, side, ST1, CS, CS + 2 * DFF, DFF}; pg8::gemm_phase<pg8::EpiFfn, pg8::StaticOrder>(ldsg, g, S, E, nullptr, wv); }
          GSYNC();
          ffn_fixup_phase(side, cw, cb, ZB, wv);
          GSYNC();
          { stagger(STAG_F32); pg8::Gemm g{ZB, (const bf16_t*)(ws + OFF_WT_DOWN + layer * SZ_WT_DOWN), MTOK, DM, DFF}; pg8::StaticOrder S; S.init(MTOK, DM, G, fresh_bid());
            pg8::EpiResLn<true> E{R, R, ACTB, DM, ST1, g1, b1, ST2, xl}; pg8::gemm_phase<pg8::EpiResLn<true>, pg8::StaticOrder>(ldsg, g, S, E, nullptr, wv); }
          GSYNC(); }
        { pg8::Gemm g{PB + (size_t)layer * MTOK * PLE, (const bf16_t*)(ws + OFF_WT_PROJ + layer * SZ_WT_PROJ), MTOK, DM, PLE}; pg8::StaticOrder S; S.init(MTOK, DM, G, fresh_bid());
          pg8::EpiBf16<0> E{PPB, DM, nullptr, 0, 0}; pg8::gemm_phase<pg8::EpiBf16<0>, pg8::StaticOrder>(ldsg, g, S, E, nullptr, wv); }
        asm volatile("s_waitcnt vmcnt(0)" ::: "memory"); __syncthreads(); __builtin_amdgcn_fence(__ATOMIC_ACQUIRE, "agent"); asm volatile("s_waitcnt vmcnt(0)" ::: "memory");
        { stagger(STAG_F32); pg8::Gemm g{ACTB, (const bf16_t*)(ws + OFF_WT_GATE + layer * SZ_WT_GATE), MTOK, DM, DM}; pg8::StaticOrder S; S.init(MTOK, DM, G, fresh_bid());
          pg8::EpiPle E{R, PPB, ST2, CS + 4 * DFF, CS + 4 * DFF + DM, g2, b2, (layer == 0) ? HFB : nullptr, DM}; pg8::gemm_phase<pg8::EpiPle, pg8::StaticOrder>(ldsg, g, S, E, nullptr, wv); }
        if (layer == 0) GSYNC();
    }
}

#undef ws
#undef R
#undef ACTB
#undef PB
#undef ZB
#undef HFB
#undef PPB
#undef barw
#undef ST1
#undef ST2
#undef xl
#undef CS
#undef g1
#undef b1
#undef g2
#undef b2
#undef P
extern "C" void kernel_launch(void* const* d_in, const int* in_sizes, int n_in, void* d_out, int out_size, void* d_ws, size_t ws_size, hipStream_t stream) {
    static int grid_blocks = 0;
    if (grid_blocks == 0) {
        if (n_in != 24 || out_size != MTOK * DM || ws_size < WS_END) { fprintf(stderr, "kernel_launch: unexpected shapes (n_in %d out %d ws %zu need %zu)\n", n_in, out_size, ws_size, (size_t)WS_END); grid_blocks = -1; return; }
        int dev = 0, cus = 0, per_cu = 0;
        hipGetDevice(&dev); hipDeviceGetAttribute(&cus, hipDeviceAttributeMultiprocessorCount, dev);
        if (hipFuncSetAttribute((const void*)hybrid_fwd, hipFuncAttributeMaxDynamicSharedMemorySize, LDS_BYTES) != hipSuccess) { fprintf(stderr, "kernel_launch: hipFuncSetAttribute failed\n"); grid_blocks = -1; return; }
        if (hipOccupancyMaxActiveBlocksPerMultiprocessor(&per_cu, (const void*)hybrid_fwd, 512, LDS_BYTES) != hipSuccess || per_cu < 1) { fprintf(stderr, "kernel_launch: occupancy query gave %d\n", per_cu); per_cu = 1; }
        (void)hipGetLastError();
        grid_blocks = cus * 1;
    }
    if (grid_blocks < 0) return;
    Params p{};
    for (int i = 0; i < 24; ++i) p.in[i] = (const float*)d_in[i];
    p.out = (float*)d_out; p.ws = (unsigned char*)d_ws;
    void* args[] = {&p};
    hipError_t e = hipLaunchCooperativeKernel((const void*)hybrid_fwd, dim3(grid_blocks), dim3(512), args, LDS_BYTES, stream);
    if (e != hipSuccess) fprintf(stderr, "cooperative launch failed: %s (grid %d)\n", hipGetErrorString(e), grid_blocks);
}
```

```cpp
#include <hip/hip_runtime.h>
#include <hip/hip_cooperative_groups.h>
#include <cstdio>
namespace cg = cooperative_groups;
__device__ __forceinline__ int fresh_tid(int wv) { int l; asm volatile("v_mbcnt_lo_u32_b32 %0, -1, 0\n\tv_mbcnt_hi_u32_b32 %0, -1, %0" : "=v"(l)); return (wv << 6) | l; }
__device__ __forceinline__ int fresh_bid() { int b = (int)blockIdx.x; asm volatile("" : "+s"(b)); return b; }
namespace pg8 {
#define PG8_LAS __attribute__((address_space(3)))
typedef unsigned short bf16_t;
typedef short bf16x8 __attribute__((ext_vector_type(8)));
typedef float f32x4 __attribute__((ext_vector_type(4)));
typedef unsigned u32x4 __attribute__((ext_vector_type(4)));
constexpr int BM = 256, BK = 64, HALF = 128, HTB = HALF * BK * 2  , STAGE_BYTES = 8 * HTB, NXCD = 8, WGM = 8;

__host__ __device__ __forceinline__ int lds_byte(int r, int c) { const int st = (r >> 4) * 2 + (c >> 5), rr = r & 15, cc = c & 31, ob = rr * 64 + cc * 2; return st * 1024 + (ob ^ (((ob >> 9) & 1) << 5)); }
__host__ __device__ __forceinline__ void stage_rc(int b, int& R, int& C) { const int st = b / 1024, sb = b % 1024, swz = sb ^ (((sb >> 9) & 1) << 5); R = (st >> 1) * 16 + swz / 64; C = (st & 1) * 32 + (swz % 64) / 2; }
__host__ __device__ __forceinline__ int perm32(int rho) { const int n = rho >> 4, i = rho & 15; return 8 * (i >> 2) + 4 * n + (i & 3); }

struct Unit { int pm, pn; };
struct Gemm { const bf16_t* A; const bf16_t* Bt; int M, N, K; };

struct StaticOrder {
    int nM, nN, nwg, G, c;
    __host__ __device__ void init(int M, int N, int G_, int c_) { nM = M / BM; nN = N / BM; nwg = nM * nN; G = G_; c = c_; }
    __host__ __device__ bool next(int i, Unit& u) const {
        const long L = (long)i * G + c; if (L >= nwg) return false;
        int wgid = (int)L; { const int q = nwg / NXCD, r = nwg % NXCD, xcd = wgid % NXCD, off = wgid / NXCD; wgid = (xcd < r ? xcd * (q + 1) : r * (q + 1) + (xcd - r) * q) + off; }
        const int nig = WGM * nN, gid = wgid / nig, fm = gid * WGM, gsz = (nM - fm) < WGM ? (nM - fm) : WGM;
        u.pm = fm + ((wgid % nig) % gsz); u.pn = (wgid % nig) / gsz; return true;
    }
    __device__ __forceinline__ void a_ready(const Unit&) const {}
    __device__ __forceinline__ void done(const Unit&) const {}
};
__device__ __forceinline__ unsigned cvt_pk_bf16(float lo, float hi) { unsigned r; asm volatile("v_cvt_pk_bf16_f32 %0, %1, %2" : "=v"(r) : "v"(lo), "v"(hi)); return r; }
typedef float f32x2 __attribute__((ext_vector_type(2)));
__device__ __forceinline__ f32x2 gelu_pk(f32x2 v) {
    const f32x2 av = __builtin_elementwise_abs(v), d = av * 0.2316418882f + 1.0f;
    f32x2 t; t.x = __builtin_amdgcn_rcpf(d.x); t.y = __builtin_amdgcn_rcpf(d.y);
    f32x2 q = t * 0.5307027145f + (-0.7265760135f); q = q * t + 0.7107068705f; q = q * t + (-0.142248368f); q = q * t + 0.127414796f; q = q * t;
    const f32x2 s = (v * v) * (-0.72134752044f);
    f32x2 e; e.x = __builtin_amdgcn_exp2f(s.x); e.y = __builtin_amdgcn_exp2f(s.y);
    const f32x2 m = v * (q * e), r = v - m;
    f32x2 o; o.x = v.x < 0.f ? m.x : r.x; o.y = v.y < 0.f ? m.y : r.y; return o;
}

struct EpiF32 {
    static constexpr bool PERM = false, AFTER_DRAIN = false, APERM = false;
    float* C; int ldc; const float* bias;
    __device__ __forceinline__ void operator()(const f32x4 (&acc)[2][2][4][2], const Unit& u, int wr, int wc, int fr, int fq) const {
        const int row0 = u.pm * BM + wr * 64 + fr, col0 = u.pn * BM + wc * 32 + 4 * fq;
        f32x4 bv[2][2];
#pragma unroll
        for (int bj = 0; bj < 2; ++bj)
#pragma unroll
            for (int n = 0; n < 2; ++n) bv[bj][n] = bias ? *(const f32x4*)(bias + col0 + bj * HALF + n * 16) : (f32x4){0.f, 0.f, 0.f, 0.f};
#pragma unroll
        for (int ai = 0; ai < 2; ++ai)
#pragma unroll
            for (int m = 0; m < 4; ++m) { float* rowp = C + (size_t)(row0 + ai * HALF + m * 16) * ldc + col0;
#pragma unroll
                for (int bj = 0; bj < 2; ++bj)
#pragma unroll
                    for (int n = 0; n < 2; ++n) *(f32x4*)(rowp + bj * HALF + n * 16) = acc[ai][bj][m][n] + bv[bj][n]; }
    }
};
template <int ACT  > struct EpiBf16 {
    static constexpr bool PERM = true, AFTER_DRAIN = false, APERM = false;
    bf16_t* O; int ldc; const float* bias; int split_cols; size_t split_stride;
    __device__ __forceinline__ void operator()(const f32x4 (&acc)[2][2][4][2], const Unit& u, int wr, int wc, int fr, int fq) const {
        const int row0 = u.pm * BM + wr * 64 + fr; int colt = u.pn * BM; bf16_t* base = O;
        if (split_cols) { const int t = colt / split_cols; base += (size_t)t * split_stride; colt -= t * split_cols; }
        const int col0 = colt + wc * 32 + 8 * fq, bcol0 = u.pn * BM + wc * 32 + 8 * fq;
        f32x4 bv[2][2];
#pragma unroll
        for (int bj = 0; bj < 2; ++bj)
#pragma unroll
            for (int n = 0; n < 2; ++n) bv[bj][n] = bias ? *(const f32x4*)(bias + bcol0 + bj * HALF + 4 * n) : (f32x4){0.f, 0.f, 0.f, 0.f};
#pragma unroll
        for (int ai = 0; ai < 2; ++ai)
#pragma unroll
            for (int m = 0; m < 4; ++m) { bf16_t* rowp = base + (size_t)(row0 + ai * HALF + m * 16) * ldc + col0;
#pragma unroll
                for (int bj = 0; bj < 2; ++bj) { f32x4 v0 = acc[ai][bj][m][0] + bv[bj][0], v1 = acc[ai][bj][m][1] + bv[bj][1];
                    if (ACT == 1) { f32x2 a = gelu_pk((f32x2){v0[0], v0[1]}), b = gelu_pk((f32x2){v0[2], v0[3]}), c = gelu_pk((f32x2){v1[0], v1[1]}), d = gelu_pk((f32x2){v1[2], v1[3]});
                        v0 = (f32x4){a.x, a.y, b.x, b.y}; v1 = (f32x4){c.x, c.y, d.x, d.y}; }
                    if (ACT == 2) {
#pragma unroll
                        for (int j = 0; j < 4; ++j) { v0[j] = 0.5f * v0[j] * (1.0f + erff(v0[j] * 0.70710678f)); v1[j] = 0.5f * v1[j] * (1.0f + erff(v1[j] * 0.70710678f)); } }
                    u32x4 w; w.x = cvt_pk_bf16(v0[0], v0[1]); w.y = cvt_pk_bf16(v0[2], v0[3]); w.z = cvt_pk_bf16(v1[0], v1[1]); w.w = cvt_pk_bf16(v1[2], v1[3]);
                    *(u32x4*)(rowp + bj * HALF) = w; } }
    }
};
__device__ __forceinline__ void row_mu_rstd(const float* st, int row, float& mu, float& rstd) {
    const f32x4 s = *(const f32x4*)(st + (size_t)row * 8), q = *(const f32x4*)(st + (size_t)row * 8 + 4);
    mu = ((s[0] + s[1]) + (s[2] + s[3])) * (1.0f / 1024.0f); const float var = fmaxf(((q[0] + q[1]) + (q[2] + q[3])) * (1.0f / 1024.0f) - mu * mu, 0.f);
    rstd = 1.0f / sqrtf(var + 1e-5f);
}
template <bool AP> __device__ __forceinline__ void wave_row_stats(const float* st, int pm, int wr, int fr, int fq, float (&mu)[8], float (&rs)[8]) {
    const int lane = fq * 16 + fr; float ma, ra, mb, rb;
    row_mu_rstd(st, AP ? pm * BM + wr * 128 + lane : pm * BM + wr * 64 + lane, ma, ra);
    row_mu_rstd(st, AP ? pm * BM + wr * 128 + 64 + lane : pm * BM + HALF + wr * 64 + lane, mb, rb);
#pragma unroll
    for (int j = 0; j < 8; ++j) { const int src = (j & 3) * 16 + fr; mu[j] = __shfl(j < 4 ? ma : mb, src); rs[j] = __shfl(j < 4 ? ra : rb, src); }
}
template <bool LNB> struct EpiResLn {
    static constexpr bool PERM = true, AFTER_DRAIN = false, APERM = false;
    const float* base; float* out; bf16_t* outb; int ldc; const float* bst; const float* bg; const float* bb; float* ost; PG8_LAS float* xl;
    __device__ __forceinline__ void operator()(const f32x4 (&acc)[2][2][4][2], const Unit& u, int wr, int wc, int fr, int fq) const {
        typedef unsigned u32x2v __attribute__((ext_vector_type(2))); typedef float f32x2v __attribute__((ext_vector_type(2)));
        asm volatile("" : "+v"(fr), "+v"(fq));
        const int row0 = u.pm * BM + wr * 64 + fr, col0 = u.pn * BM + wc * 32 + 8 * fq, lane = fq * 16 + fr;
        const unsigned lo = (unsigned)row0 * (unsigned)ldc + (unsigned)col0;
#define ERL_OFF(j, g) ((size_t)((((j) >> 2) * HALF + ((j) & 3) * 16) * ldc + ((g) >> 1) * HALF + ((g) & 1) * 4) + lo)
        f32x4 gvv[4], bvv[4]; float ma = 0.f, ra = 1.f, mb = 0.f, rb = 1.f;
        if constexpr (LNB) {
#pragma unroll
            for (int g = 0; g < 4; ++g) { const int cc = col0 + (g >> 1) * HALF + (g & 1) * 4; gvv[g] = *(const f32x4*)(bg + cc); bvv[g] = *(const f32x4*)(bb + cc); }
            row_mu_rstd(bst, u.pm * BM + wr * 64 + lane, ma, ra); row_mu_rstd(bst, u.pm * BM + HALF + wr * 64 + lane, mb, rb); }
        constexpr int DIST = LNB ? 1 : 2, NB = DIST + 1;
        f32x4 buf[NB][4];
#pragma unroll
        for (int jp = 0; jp < DIST; ++jp)
#pragma unroll
            for (int g = 0; g < 4; ++g) buf[jp][g] = *(const f32x4*)(base + ERL_OFF(jp, g));
#pragma unroll
        for (int j = 0; j < 8; ++j) {
            if (j + DIST < 8) {
#pragma unroll
                for (int g = 0; g < 4; ++g) buf[(j + DIST) % NB][g] = *(const f32x4*)(base + ERL_OFF(j + DIST, g)); }
            float mu = 0.f, rs = 1.f; if constexpr (LNB) { const int src = (j & 3) * 16 + fr; mu = __shfl(j < 4 ? ma : mb, src); rs = __shfl(j < 4 ? ra : rb, src); }
            float s = 0.f, q = 0.f; u32x2v wlo;
#pragma unroll
            for (int g = 0; g < 4; ++g) { const size_t p = ERL_OFF(j, g); f32x4 bs = buf[j % NB][g]; if constexpr (LNB) bs = (bs - mu) * rs * gvv[g] + bvv[g];
                const f32x4 o = bs * 1.41421356237f   + acc[j >> 2][g >> 1][j & 3][g & 1]; *(f32x4*)(out + p) = o;
                const unsigned w0 = cvt_pk_bf16(o[0], o[1]), w1 = cvt_pk_bf16(o[2], o[3]);
                if ((g & 1) == 0) { wlo.x = w0; wlo.y = w1; } else { u32x4 wv; wv.x = wlo.x; wv.y = wlo.y; wv.z = w0; wv.w = w1; *(u32x4*)(outb + p - 4) = wv; }
                s += (o[0] + o[1]) + (o[2] + o[3]); q += (o[0] * o[0] + o[1] * o[1]) + (o[2] * o[2] + o[3] * o[3]); }
            s += __shfl_xor(s, 16); s += __shfl_xor(s, 32); q += __shfl_xor(q, 16); q += __shfl_xor(q, 32);
            if (fq == 0) *(PG8_LAS f32x2v*)(xl + (((j >> 2) * HALF + wr * 64 + (j & 3) * 16 + fr) * 4 + wc) * 2) = (f32x2v){s, q};
            asm volatile("" ::: "memory"); }
#undef ERL_OFF
        asm volatile("s_waitcnt lgkmcnt(0)" ::: "memory"); __builtin_amdgcn_s_barrier(); asm volatile("" ::: "memory");
        const int hl = wc * 64 + lane;
        if (hl < 128) { const int rl = (hl >> 6) * HALF + wr * 64 + (hl & 63); const f32x4 a = *(const PG8_LAS f32x4*)(xl + rl * 8), b = *(const PG8_LAS f32x4*)(xl + rl * 8 + 4);
            float* sp = ost + (size_t)(u.pm * BM + rl) * 8 + u.pn; sp[0] = (a[0] + a[2]) + (b[0] + b[2]); sp[4] = (a[1] + a[3]) + (b[1] + b[3]); }
    }
};
struct EpiPle {
    static constexpr bool PERM = true, AFTER_DRAIN = false, APERM = false;
    float* R; const bf16_t* PP; const float* st; const float* csum; const float* cbias; const float* lg; const float* lb; bf16_t* xb; int ldc;
    __device__ __forceinline__ void operator()(const f32x4 (&acc)[2][2][4][2], const Unit& u, int wr, int wc, int fr, int fq) const {
        typedef unsigned u32x2v __attribute__((ext_vector_type(2)));
        asm volatile("" : "+v"(fr), "+v"(fq));
        const int row0 = u.pm * BM + wr * 64 + fr, col0 = u.pn * BM + wc * 32 + 8 * fq, lane = fq * 16 + fr;
        const unsigned lo = (unsigned)row0 * (unsigned)ldc + (unsigned)col0;
#define EPL_OFF(j, bj, n) ((size_t)((((j) >> 2) * HALF + ((j) & 3) * 16) * ldc + (bj) * HALF + (n) * 4) + lo)
        float ma, ra, mb, rb; row_mu_rstd(st, u.pm * BM + wr * 64 + lane, ma, ra); row_mu_rstd(st, u.pm * BM + HALF + wr * 64 + lane, mb, rb);
#pragma unroll
        for (int bj = 0; bj < 2; ++bj) { f32x4 cs[2], cb[2], gv[2], bv[2];
#pragma unroll
            for (int n = 0; n < 2; ++n) { const int cc = col0 + bj * HALF + n * 4; cs[n] = *(const f32x4*)(csum + cc); cb[n] = *(const f32x4*)(cbias + cc); gv[n] = *(const f32x4*)(lg + cc); bv[n] = *(const f32x4*)(lb + cc); }
            f32x4 rv[2][2]; u32x4 pv[2];
#pragma unroll
            for (int n = 0; n < 2; ++n) rv[0][n] = *(const f32x4*)(R + EPL_OFF(0, bj, n));
            pv[0] = *(const u32x4*)(PP + EPL_OFF(0, bj, 0));
#pragma unroll
            for (int j = 0; j < 8; ++j) {
                if (j + 1 < 8) {
#pragma unroll
                    for (int n = 0; n < 2; ++n) rv[(j + 1) & 1][n] = *(const f32x4*)(R + EPL_OFF(j + 1, bj, n));
                    pv[(j + 1) & 1] = *(const u32x4*)(PP + EPL_OFF(j + 1, bj, 0)); }
                const int src = (j & 3) * 16 + fr; const float mu = __shfl(j < 4 ? ma : mb, src), rs = __shfl(j < 4 ? ra : rb, src); u32x2v xlo;
#pragma unroll
                for (int n = 0; n < 2; ++n) { const size_t p = EPL_OFF(j, bj, n);
                    const f32x4 a = (acc[j >> 2][bj][j & 3][n] - cs[n] * mu) * rs + cb[n]; const f32x4 x = (rv[j & 1][n] - mu) * rs * gv[n] + bv[n]; u32x2v pq; pq.x = n ? pv[j & 1].z : pv[j & 1].x; pq.y = n ? pv[j & 1].w : pv[j & 1].y;
                    const f32x4 pp = (f32x4){__uint_as_float(pq.x << 16), __uint_as_float(pq.x & 0xffff0000u), __uint_as_float(pq.y << 16), __uint_as_float(pq.y & 0xffff0000u)}; f32x4 o;
#pragma unroll
                    for (int t = 0; t < 4; ++t) o[t] = x[t] + pp[t] * __builtin_amdgcn_rcpf(1.0f + __builtin_amdgcn_exp2f(a[t] * -1.44269504089f));
                    *(f32x4*)(R + p) = o;
                    if (xb) { const unsigned w0 = cvt_pk_bf16(o[0], o[1]), w1 = cvt_pk_bf16(o[2], o[3]);
                        if (n == 0) { xlo.x = w0; xlo.y = w1; } else { u32x4 wv; wv.x = xlo.x; wv.y = xlo.y; wv.z = w0; wv.w = w1; *(u32x4*)(xb + p - 4) = wv; } } }
                asm volatile("" ::: "memory"); } }
#undef EPL_OFF
    }
};
template <int CTRL> __device__ __forceinline__ float dpp_keep(float old, float src) {
    return __builtin_bit_cast(float, __builtin_amdgcn_update_dpp(__builtin_bit_cast(int, old), __builtin_bit_cast(int, src), CTRL, 0xf, 0xf, false)); }
struct EpiFfn {
    static constexpr bool PERM = true, AFTER_DRAIN = false, APERM = true;
    bf16_t* H; const float* cw; const float* cb; float* side; const float* st; const float* csum; const float* cbias; int dff;
    __device__ __forceinline__ void operator()(f32x4 (&acc)[2][2][4][2], const Unit& u, int wr, int wc, int fr, int fq) const {
        asm volatile("" : "+v"(fr), "+v"(fq));
        const int ca = u.pn * 128 + wc * 32 + 8 * fq; const int rowb = u.pm * BM + wr * 128 + fr; const int blk = u.pm * 2 + wr;
        const size_t sstride = (size_t)512 * 2 * dff;
        { f32x4 csa[2], cba[2], csg[2], cbg[2];
#pragma unroll
          for (int n = 0; n < 2; ++n) { const int cc = ca + 4 * n; csa[n] = *(const f32x4*)(csum + cc); cba[n] = *(const f32x4*)(cbias + cc); csg[n] = *(const f32x4*)(csum + dff + cc); cbg[n] = *(const f32x4*)(cbias + dff + cc); }
          float mu8[8], rs8[8]; wave_row_stats<true>(st, u.pm, wr, fr, fq, mu8, rs8);
#pragma unroll
          for (int j8 = 0; j8 < 8; ++j8) { const float mu = mu8[j8], rs = rs8[j8]; const int ai = j8 >> 2, m = j8 & 3;
#pragma unroll
              for (int n = 0; n < 2; ++n) { acc[ai][0][m][n] = (acc[ai][0][m][n] - csa[n] * mu) * rs + cba[n]; acc[ai][1][m][n] = (acc[ai][1][m][n] - csg[n] * mu) * rs + cbg[n]; }
              if (j8 & 1) asm volatile("" ::: "memory"); }
          asm volatile("" ::: "memory"); }
        f32x4 w0[2], w1[2], w2[2], bb[2];
#pragma unroll
        for (int n = 0; n < 2; ++n) { const int cc = ca + 4 * n; w0[n] = *(const f32x4*)(cw + cc); w1[n] = *(const f32x4*)(cw + dff + cc); w2[n] = *(const f32x4*)(cw + 2 * dff + cc); bb[n] = *(const f32x4*)(cb + cc); }
#pragma unroll
        for (int j8 = 0; j8 < 8; ++j8) { const int ai = j8 >> 2, m = j8 & 3; u32x4 wv;
#pragma unroll
            for (int n = 0; n < 2; ++n) { const f32x4 X = acc[ai][0][m][n], G = acc[ai][1][m][n]; f32x4 a;
#pragma unroll
                for (int e = 0; e < 4; ++e) { float o1 = 0.f, o2 = 0.f;
                    if (j8 > 0) { const float xp = acc[(j8 - 1) >> 2][0][(j8 - 1) & 3][n][e]; o1 = dpp_keep<0x121>(0.f, xp); o2 = dpp_keep<0x122>(0.f, xp); }
                    const float p1 = dpp_keep<0x111>(o1, X[e]), p2 = dpp_keep<0x112>(o2, X[e]);
                    a[e] = bb[n][e] + w2[n][e] * X[e] + w1[n][e] * p1 + w0[n][e] * p2; }
                const f32x2 g0 = gelu_pk((f32x2){a[0], a[1]}), g1 = gelu_pk((f32x2){a[2], a[3]});
                const unsigned lo = cvt_pk_bf16(g0.x * G[0], g0.y * G[1]), hi = cvt_pk_bf16(g1.x * G[2], g1.y * G[3]);
                if (n == 0) { wv.x = lo; wv.y = hi; } else { wv.z = lo; wv.w = hi; }
                if (j8 == 0 && fr < 2) { float* sp = side + ((size_t)blk * 2 + fr) * dff + ca + 4 * n; *(f32x4*)(sp + sstride) = X; *(f32x4*)(sp + 2 * sstride) = G; }
                if (j8 == 7 && fr >= 14) { float* sp = side + ((size_t)blk * 2 + (fr - 14)) * dff + ca + 4 * n; *(f32x4*)sp = X; } }
            *(u32x4*)(H + (size_t)(rowb + 16 * j8) * dff + ca) = wv; asm volatile("" ::: "memory"); }
    }
};
template <class Epi, class Sched, bool STAMP = false>
__device__ __forceinline__ void gemm_phase(PG8_LAS unsigned char* lds, const Gemm g, const Sched& S, const Epi& E, unsigned long long* stamps, int wv) {
    const int tid = fresh_tid(wv), wid = __builtin_amdgcn_readfirstlane(tid >> 6), lane = tid & 63, wr = wid >> 2, wc = wid & 3, fr = lane & 15, fq = lane >> 4;
    const int K = g.K, nt = K / BK;
    int ts_lo = 0, ts_hi = 0, nts = 0; const unsigned long long rt_entry = STAMP ? (unsigned long long)wall_clock64() : 0ull;
#define PG8_STAMP() do { if (STAMP && wid == 0 && nts < 64) { const unsigned long long _c = (unsigned long long)clock64(); \
        ts_lo = (lane == nts) ? (int)(unsigned)_c : ts_lo; ts_hi = (lane == nts) ? (int)(unsigned)(_c >> 32) : ts_hi; ++nts; } } while (0)
    PG8_STAMP();
    unsigned voffA[2], voffB[2];
#pragma unroll
    for (int i = 0; i < 2; ++i) { int R, C; stage_rc(tid * 16 + i * 8192, R, C); const int Rb = Epi::PERM ? ((R & ~31) + perm32(R & 31)) : R;
        voffA[i] = (unsigned)((Epi::APERM ? (128 * (R >> 6) + (R & 63)) : R) * K + C) * 2u; voffB[i] = (unsigned)(Rb * K + C) * 2u; }
    const size_t kstep = (size_t)(BK * 2);
    const size_t hstep = (size_t)HALF * K * 2;
    const size_t tstep = 2 * hstep; const size_t hstepA = Epi::APERM ? (size_t)64 * K * 2 : hstep;
    const unsigned ldsw = (unsigned)wid * 1024u;
    const int aoff = lds_byte(wr * 64 + fr, fq * 8), boff = lds_byte(wc * 32 + fr, fq * 8);
#define PG8_SA(b, h) (((b) * 2 + (h)) * HTB)
#define PG8_SB(b, h) ((4 + (b) * 2 + (h)) * HTB)
#define PG8_STAGE(bufoff, gbase, voff) do { _Pragma("unroll") for (int _i = 0; _i < 2; ++_i) \
        __builtin_amdgcn_global_load_lds((const unsigned*)((const char*)(gbase) + (voff)[_i]), (PG8_LAS unsigned*)(lds + (bufoff) + ldsw + _i * 8192), 16, 0, 0); } while (0)
#define PG8_LDA(dst, b, h) do { _Pragma("unroll") for (int m = 0; m < 4; ++m) _Pragma("unroll") for (int k = 0; k < 2; ++k) dst[m][k] = *(const PG8_LAS bf16x8*)(lds + PG8_SA(b, h) + aoff + m * 2048 + k * 1024); } while (0)
#define PG8_LDB(dst, b, h) do { _Pragma("unroll") for (int n = 0; n < 2; ++n) _Pragma("unroll") for (int k = 0; k < 2; ++k) dst[n][k] = *(const PG8_LAS bf16x8*)(lds + PG8_SB(b, h) + boff + n * 2048 + k * 1024); } while (0)
#define PG8_MMA(ai, bj, At, Bt) do { __builtin_amdgcn_s_setprio(1); _Pragma("unroll") for (int m = 0; m < 4; ++m) _Pragma("unroll") for (int n = 0; n < 2; ++n) _Pragma("unroll") for (int k = 0; k < 2; ++k) \
        acc[ai][bj][m][n] = __builtin_amdgcn_mfma_f32_16x16x32_bf16(Bt[n][k], At[m][k], acc[ai][bj][m][n], 0, 0, 0); __builtin_amdgcn_s_setprio(0); } while (0)
#define PG8_WAIT_V(n) asm volatile("s_waitcnt vmcnt(" #n ")" ::: "memory")
#define PG8_WAIT_L(n) asm volatile("s_waitcnt lgkmcnt(" #n ")" ::: "memory")
#define PG8_BAR __builtin_amdgcn_s_barrier()
#define PG8_SCHED __builtin_amdgcn_sched_barrier(0)
    Unit cur, nxt; int ui = 0;
    if (!S.next(0, cur)) return;
    f32x4 acc[2][2][4][2];
#pragma unroll
    for (int a = 0; a < 2; ++a)
#pragma unroll
        for (int b = 0; b < 2; ++b)
#pragma unroll
            for (int m = 0; m < 4; ++m)
#pragma unroll
                for (int n = 0; n < 2; ++n) acc[a][b][m][n] = (f32x4){0.f, 0.f, 0.f, 0.f};
    bf16x8 At[4][2], B0[2][2], B1[2][2];
    const char* cA = (const char*)g.A + (size_t)cur.pm * tstep; const char* cB = (const char*)g.Bt + (size_t)cur.pn * tstep;
    S.a_ready(cur);
    PG8_STAGE(PG8_SB(0, 0), cB, voffB); PG8_STAGE(PG8_SA(0, 0), cA, voffA); PG8_STAGE(PG8_SB(0, 1), cB + hstep, voffB); PG8_STAGE(PG8_SA(0, 1), cA + hstepA, voffA);
    if (wr == 1) PG8_BAR;
    PG8_WAIT_V(4); PG8_BAR;
    PG8_STAGE(PG8_SB(1, 0), cB + kstep, voffB); PG8_STAGE(PG8_SA(1, 0), cA + kstep, voffA); PG8_STAGE(PG8_SB(1, 1), cB + hstep + kstep, voffB);
    PG8_WAIT_V(6); PG8_BAR;
    PG8_STAMP();
    for (;;) {
        const bool has_next = S.next(ui + 1, nxt);
        const char* nA = has_next ? (const char*)g.A + (size_t)nxt.pm * tstep : cA; const char* nB = has_next ? (const char*)g.Bt + (size_t)nxt.pn * tstep : cB;
        for (int t = 0; t < nt; t += 2) {
            const bool last = (t == nt - 2);
            const char* a1 = cA + (size_t)(t + 1) * kstep;
            const char* a2 = last ? nA : cA + (size_t)(t + 2) * kstep; const char* b2 = last ? nB : cB + (size_t)(t + 2) * kstep;
            const char* a3 = a2 + kstep; const char* b3 = b2 + kstep;
            if (last && has_next) S.a_ready(nxt);
            PG8_LDB(B0, 0, 0); PG8_SCHED; PG8_LDA(At, 0, 0); PG8_STAGE(PG8_SA(1, 1), a1 + hstepA, voffA);
            PG8_WAIT_L(8); PG8_BAR; PG8_WAIT_L(0); PG8_MMA(0, 0, At, B0); PG8_BAR; PG8_SCHED;
            PG8_LDB(B1, 0, 1); PG8_STAGE(PG8_SB(0, 0), b2, voffB);
            PG8_BAR; PG8_WAIT_L(0); PG8_MMA(0, 1, At, B1); PG8_BAR;
            PG8_LDA(At, 0, 1); PG8_STAGE(PG8_SA(0, 0), a2, voffA);
            PG8_BAR; PG8_WAIT_L(0); PG8_MMA(1, 0, At, B0); PG8_BAR; PG8_SCHED;
            PG8_STAGE(PG8_SB(0, 1), b2 + hstep, voffB);
            PG8_WAIT_V(6); PG8_BAR; PG8_MMA(1, 1, At, B1); PG8_BAR;
            PG8_LDB(B0, 1, 0); PG8_SCHED; PG8_LDA(At, 1, 0); PG8_STAGE(PG8_SA(0, 1), a2 + hstepA, voffA);
            PG8_WAIT_L(8); PG8_BAR; PG8_WAIT_L(0); PG8_MMA(0, 0, At, B0); PG8_BAR; PG8_SCHED;
            PG8_LDB(B1, 1, 1); PG8_STAGE(PG8_SB(1, 0), b3, voffB);
            PG8_BAR; PG8_WAIT_L(0); PG8_MMA(0, 1, At, B1); PG8_BAR;
            PG8_LDA(At, 1, 1); PG8_STAGE(PG8_SA(1, 0), a3, voffA);
            PG8_BAR; PG8_WAIT_L(0); PG8_MMA(1, 0, At, B0); PG8_BAR; PG8_SCHED;
            PG8_STAGE(PG8_SB(1, 1), b3 + hstep, voffB);
            PG8_WAIT_V(6); PG8_BAR; PG8_MMA(1, 1, At, B1); PG8_BAR;
        }
        PG8_STAMP();
        if constexpr (!Epi::AFTER_DRAIN) { E(acc, cur, wr, wc, fr, fq); S.done(cur); }
        PG8_STAMP();
        if (!has_next) break;
#pragma unroll
        for (int a = 0; a < 2; ++a)
#pragma unroll
            for (int b = 0; b < 2; ++b)
#pragma unroll
                for (int m = 0; m < 4; ++m)
#pragma unroll
                    for (int n = 0; n < 2; ++n) acc[a][b][m][n] = (f32x4){0.f, 0.f, 0.f, 0.f};
        cur = nxt; cA = nA; cB = nB; ++ui;
    }
    PG8_WAIT_V(0);
    if (wr == 0) PG8_BAR;
    PG8_BAR;
    if constexpr (Epi::AFTER_DRAIN) { E.fused(acc, cur, wr, wc, fr, fq, lds, wid, lane); S.done(cur); }
    PG8_STAMP();
    if (STAMP && wid == 0) { stamps[lane] = lane < nts ? (((unsigned long long)(unsigned)ts_hi << 32) | (unsigned)ts_lo) : 0ull;
        if (lane == 62) stamps[62] = rt_entry; if (lane == 63) stamps[63] = (unsigned long long)wall_clock64(); }
#undef PG8_STAMP
#undef PG8_SA
#undef PG8_SB
#undef PG8_STAGE
#undef PG8_LDA
#undef PG8_LDB
#undef PG8_MMA
#undef PG8_WAIT_V
#undef PG8_WAIT_L
#undef PG8_BAR
#undef PG8_SCHED
}
}
#define XB_TMO      128
#define XB_XCNT(j)  (256  + 64 * (j))
#define XB_XSUB(j)  (1280 + 64 * (j))
#define XB_XGEN(j)  (2304 + 64 * (j))
#define XB_TOP      3328
#define XB_TOPGEN   3392
#define XCD_BAR_WORDS 3456
#define XB_SPIN_CAP (1u << 18)
#define LAS __attribute__((address_space(3)))

__device__ __forceinline__ unsigned xb_ld(unsigned* p)              { return __hip_atomic_load(p, __ATOMIC_RELAXED, __HIP_MEMORY_SCOPE_AGENT); }
__device__ __forceinline__ unsigned xb_add(unsigned* p, unsigned v) { return __hip_atomic_fetch_add(p, v, __ATOMIC_RELAXED, __HIP_MEMORY_SCOPE_AGENT); }
__device__ __forceinline__ unsigned xb_xcc_id() { return (unsigned)__builtin_amdgcn_s_getreg((3 << 11) | 20) & 0xFu; }
#define XB_SPIN(cond, bar) do { unsigned _sp = 0; while (cond) { __builtin_amdgcn_s_sleep(1); \
    if ((++_sp & 255u) == 0u) { if (xb_ld(&(bar)[XB_TMO])) break; if (_sp > XB_SPIN_CAP) { atomicAdd(&(bar)[XB_TMO], 1u); break; } } } } while (0)

struct XcdBarrier {
    unsigned* bar; unsigned x;
    volatile LAS unsigned* st;
};

__device__ __forceinline__ XcdBarrier xcd_barrier_post(unsigned* bar, volatile LAS unsigned* st, int tid) {
    XcdBarrier b; b.bar = bar; b.x = xb_xcc_id(); b.st = st;
    if (tid == 0) (void)xb_add(&bar[XB_XCNT(b.x)], 1u);
    return b;
}
__device__ __forceinline__ void xcd_barrier_complete(unsigned* bar, unsigned x, unsigned& nloc, unsigned& nx) {
    const unsigned G = gridDim.x * gridDim.y * gridDim.z;
    unsigned sum, cnt, mine, sp = 0u;
    for (;;) {
        sum = 0u; cnt = 0u; mine = 0u;
#pragma unroll
        for (unsigned j = 0; j < 16; ++j) { const unsigned c = xb_ld(&bar[XB_XCNT(j)]); sum += c; cnt += (c > 0u) ? 1u : 0u; mine = (j == x) ? c : mine; }
        if (sum == G) break;
        __builtin_amdgcn_s_sleep(1);
        if ((++sp & 255u) == 0u) { if (xb_ld(&bar[XB_TMO])) break; if (sp > XB_SPIN_CAP) { atomicAdd(&bar[XB_TMO], 1u); break; } }
    }
    nloc = mine > 0u ? mine : 1u; nx = cnt > 0u ? cnt : 1u;
}

__device__ __forceinline__ void xcd_barrier(const XcdBarrier& b, int tid) {
    asm volatile("s_waitcnt vmcnt(0)" ::: "memory");
    __syncthreads();
    if (tid == 0) {
        unsigned* bar = b.bar;
        __builtin_amdgcn_s_waitcnt(0);
        unsigned nloc = b.st[0], nx = b.st[1];
        if (nloc == 0u) { xcd_barrier_complete(bar, b.x, nloc, nx); b.st[0] = nloc; b.st[1] = nx; }
        const unsigned old = xb_add(&bar[XB_XSUB(b.x)], 1u);
        const unsigned gen = old / nloc;
        if (old + 1u == (gen + 1u) * nloc) {
            __builtin_amdgcn_fence(__ATOMIC_RELEASE, "agent");
            asm volatile("s_waitcnt vmcnt(0)" ::: "memory");
            const unsigned og = xb_add(&bar[XB_TOP], 1u);
            const unsigned tg = og / nx;
            if (og + 1u == (tg + 1u) * nx) xb_add(&bar[XB_TOPGEN], 1u);
            else XB_SPIN(xb_ld(&bar[XB_TOPGEN]) == tg, bar);
            __builtin_amdgcn_fence(__ATOMIC_ACQUIRE, "agent");
            xb_add(&bar[XB_XGEN(b.x)], 1u);
            asm volatile("s_waitcnt vmcnt(0)" ::: "memory");
        } else {
            XB_SPIN(xb_ld(&bar[XB_XGEN(b.x)]) == gen, bar);
            __builtin_amdgcn_fence(__ATOMIC_ACQUIRE, "agent");
            asm volatile("s_waitcnt vmcnt(0)" ::: "memory");
        }
    }
    __syncthreads();
}

typedef pg8::bf16_t bf16_t;
typedef pg8::bf16x8 bf16x8;
typedef pg8::f32x4 f32x4;
typedef float f32x2 __attribute__((ext_vector_type(2)));
constexpr int MTOK = 65536, DM = 1024, SEQL = 4096, EIN = 2048, DFF = 2816, SGUW_ = 2048, PLE = 256;
constexpr float ALPHA = 1.41421356237f, LNEPS = 1e-5f;
constexpr int XL_OFF = pg8::STAGE_BYTES + 256;
constexpr int LDS_BYTES = pg8::STAGE_BYTES + 256 + 8192;

constexpr size_t al256(size_t x) { return (x + 255) & ~(size_t)255; }
constexpr size_t OFF_WT_EIN = 0;
constexpr size_t OFF_WT_EOUT = OFF_WT_EIN + (size_t)EIN * DM * 2;
constexpr size_t OFF_WT_OIN = OFF_WT_EOUT + (size_t)DM * DM * 2;
constexpr size_t OFF_WT_OOUT = OFF_WT_OIN + (size_t)4096 * DM * 2;
constexpr size_t OFF_WT_UP = OFF_WT_OOUT + (size_t)DM * 2048 * 2;
constexpr size_t SZ_WT_UP = (size_t)2 * DFF * DM * 2;
constexpr size_t OFF_WT_DOWN = OFF_WT_UP + 2 * SZ_WT_UP;
constexpr size_t SZ_WT_DOWN = (size_t)DM * DFF * 2;
constexpr size_t OFF_WT_GATE = OFF_WT_DOWN + 2 * SZ_WT_DOWN;
constexpr size_t SZ_WT_GATE = (size_t)DM * DM * 2;
constexpr size_t OFF_WT_PROJ = OFF_WT_GATE + 2 * SZ_WT_GATE;
constexpr size_t SZ_WT_PROJ = (size_t)DM * PLE * 2;
constexpr size_t OFF_SGUW = OFF_WT_PROJ + 2 * SZ_WT_PROJ;
constexpr size_t OFF_ACTB = al256(OFF_SGUW + (size_t)8 * 128 * 128 * 2);
constexpr size_t OFF_PB = OFF_ACTB + (size_t)MTOK * DM * 2;
constexpr size_t OFF_ZBUF = OFF_PB + (size_t)2 * MTOK * PLE * 2;
constexpr size_t OFF_HF = OFF_ZBUF + (size_t)MTOK * 4096 * 2;
constexpr size_t OFF_BAR = OFF_HF + (size_t)MTOK * 2048 * 2;
constexpr size_t OFF_ST = al256(OFF_BAR + (size_t)XCD_BAR_WORDS * 4);
constexpr size_t SZ_ST = (size_t)MTOK * 8 * 4;
constexpr size_t OFF_CS = OFF_ST + 2 * SZ_ST;
constexpr size_t SZ_CS = (size_t)(2 * 2 * DFF + 2 * DM) * 4 * 2;
constexpr size_t WS_END = OFF_CS + 2 * SZ_CS;

struct Params { const float* in[24]; float* out; unsigned char* ws; };

__device__ __forceinline__ unsigned pk2(float lo, float hi) { return pg8::cvt_pk_bf16(lo, hi); }
__device__ __forceinline__ float bflo(unsigned u) { return __uint_as_float(u << 16); }
__device__ __forceinline__ float bfhi(unsigned u) { return __uint_as_float(u & 0xffff0000u); }
__device__ __forceinline__ unsigned short f2bf(float f) { unsigned u = __float_as_uint(f); u += 0x7FFFu + ((u >> 16) & 1u); return (unsigned short)(u >> 16); }
__device__ __forceinline__ void unpack8(const uint4 d, float (&f)[8]) {
    f[0] = bflo(d.x); f[1] = bfhi(d.x); f[2] = bflo(d.y); f[3] = bfhi(d.y); f[4] = bflo(d.z); f[5] = bfhi(d.z); f[6] = bflo(d.w); f[7] = bfhi(d.w); }
__device__ __forceinline__ uint4 pack8(const float (&f)[8]) { uint4 o; o.x = pk2(f[0], f[1]); o.y = pk2(f[2], f[3]); o.z = pk2(f[4], f[5]); o.w = pk2(f[6], f[7]); return o; }

template <bool UPMAP = false> __device__ __forceinline__ void transpose_w(float* tile, const float* __restrict__ src, int lds_, bf16_t* __restrict__ dst, int ldd, int K, int N, int wv) {
    const int tid = fresh_tid(wv); const int tn = N / 64, nt = (K / 128) * tn;
    for (int tix = fresh_bid(); tix < nt; tix += gridDim.x) {
        const int k0 = (tix / tn) * 128, n0 = (tix % tn) * 64; float4 v[4];
#pragma unroll
        for (int p = 0; p < 4; ++p) v[p] = *(const float4*)(src + (size_t)(k0 + (tid >> 4) + p * 32) * lds_ + n0 + (tid & 15) * 4);
#pragma unroll
        for (int p = 0; p < 4; ++p) { float* t = tile + ((tid >> 4) + p * 32) * 65 + (tid & 15) * 4; t[0] = v[p].x; t[1] = v[p].y; t[2] = v[p].z; t[3] = v[p].w; }
        __syncthreads();
        { const int nn = tid >> 3, k16 = (tid & 7) * 16; float f[8], h[8];
#pragma unroll
          for (int j = 0; j < 8; ++j) { f[j] = tile[(k16 + j) * 65 + nn]; h[j] = tile[(k16 + 8 + j) * 65 + nn]; }
          const int d0 = UPMAP ? (n0 < DFF ? 256 * (n0 >> 7) + (n0 & 127) : 256 * ((n0 - DFF) >> 7) + 128 + ((n0 - DFF) & 127)) : n0;
          bf16_t* dp = dst + (size_t)(d0 + nn) * ldd + k0 + k16; *(uint4*)dp = pack8(f); *(uint4*)(dp + 8) = pack8(h); }
        __syncthreads();
    }
}
template <bool UPMAP> __device__ __forceinline__ void transpose_fold_strip(float* tile, const float* __restrict__ src, int lds_, bf16_t* __restrict__ dst, int K, int strip,
                                                                            const float* __restrict__ g, const float* __restrict__ b, const float* __restrict__ extra, float* __restrict__ csum, float* __restrict__ cbias, int wv) {
    const int tid = fresh_tid(wv), n0 = strip * 64, nn = tid >> 3, k8 = (tid & 7) * 8; float rsum = 0.f, bsum = 0.f;
    const int d0 = UPMAP ? (n0 < DFF ? 256 * (n0 >> 7) + (n0 & 127) : 256 * ((n0 - DFF) >> 7) + 128 + ((n0 - DFF) & 127)) : n0;
    for (int k0 = 0; k0 < K; k0 += 64) {
#pragma unroll
        for (int p = 0; p < 2; ++p) { const int kk = (tid >> 4) + p * 32, n4 = (tid & 15) * 4;
            const float4 v = *(const float4*)(src + (size_t)(k0 + kk) * lds_ + n0 + n4);
            float* t = tile + kk * 65 + n4; t[0] = v.x; t[1] = v.y; t[2] = v.z; t[3] = v.w; }
        __syncthreads();
        { float f[8]; const float4 g0 = *(const float4*)(g + k0 + k8), g1 = *(const float4*)(g + k0 + k8 + 4), b0 = *(const float4*)(b + k0 + k8), b1 = *(const float4*)(b + k0 + k8 + 4);
          const float gk[8] = {g0.x, g0.y, g0.z, g0.w, g1.x, g1.y, g1.z, g1.w}, bk[8] = {b0.x, b0.y, b0.z, b0.w, b1.x, b1.y, b1.z, b1.w};
#pragma unroll
          for (int j = 0; j < 8; ++j) { const float v = tile[(k8 + j) * 65 + nn]; f[j] = gk[j] * v; bsum += bk[j] * v; }
          const uint4 o = pack8(f); float r[8]; unpack8(o, r);
#pragma unroll
          for (int j = 0; j < 8; ++j) rsum += r[j];
          *(uint4*)(dst + (size_t)(d0 + nn) * K + k0 + k8) = o; }
        __syncthreads();
    }
    rsum += __shfl_xor(rsum, 1); rsum += __shfl_xor(rsum, 2); rsum += __shfl_xor(rsum, 4);
    bsum += __shfl_xor(bsum, 1); bsum += __shfl_xor(bsum, 2); bsum += __shfl_xor(bsum, 4);
    if ((tid & 7) == 0) { csum[n0 + nn] = rsum; cbias[n0 + nn] = bsum + (extra ? extra[n0 + nn] : 0.f); }
}
__device__ __forceinline__ void convert_bf16(const float* __restrict__ src, bf16_t* __restrict__ dst, size_t n, int wv) {
    const size_t n8 = n / 8, stride = (size_t)gridDim.x * 512;
    for (size_t i = (size_t)fresh_bid() * 512 + fresh_tid(wv); i < n8; i += 4 * stride) {
        float4 a[4], b[4];
#pragma unroll
        for (int u = 0; u < 4; ++u) { const size_t ii = i + u * stride; if (ii < n8) { a[u] = *(const float4*)(src + ii * 8); b[u] = *(const float4*)(src + ii * 8 + 4); } }
#pragma unroll
        for (int u = 0; u < 4; ++u) { const size_t ii = i + u * stride; if (ii < n8) { uint4 o; o.x = pk2(a[u].x, a[u].y); o.y = pk2(a[u].z, a[u].w); o.z = pk2(b[u].x, b[u].y); o.w = pk2(b[u].z, b[u].w); *(uint4*)(dst + ii * 8) = o; } }
    }
}

template <class PP_> __device__ __forceinline__ void prep_phase(PP_ Pp, float* tile, int wv) {
#define P (*Pp)
    unsigned char* ws = P.ws;
    const int par = fresh_bid() & 1;
    for (int stg = 0; stg < 2; ++stg) { if ((stg ^ par) == 0) {
    transpose_w(tile, P.in[2], EIN, (bf16_t*)(ws + OFF_WT_EIN), DM, DM, EIN, wv);
    transpose_w(tile, P.in[6] + (size_t)512 * DM, DM, (bf16_t*)(ws + OFF_WT_EOUT) + 512, DM, 512, DM, wv);
    transpose_w(tile, P.in[7], 4096, (bf16_t*)(ws + OFF_WT_OIN), DM, DM, 4096, wv);
    transpose_w(tile, P.in[12], DM, (bf16_t*)(ws + OFF_WT_OOUT), 2048, 2048, DM, wv);
    for (int l = 0; l < 2; ++l) {
        transpose_w(tile, P.in[18] + (size_t)l * DFF * DM, DM, (bf16_t*)(ws + OFF_WT_DOWN + l * SZ_WT_DOWN), DFF, DFF, DM, wv);
        transpose_w(tile, P.in[23] + (size_t)l * PLE * DM, DM, (bf16_t*)(ws + OFF_WT_PROJ + l * SZ_WT_PROJ), PLE, PLE, DM, wv);
    }
    for (int job = fresh_bid(); job < 208; job += gridDim.x) {
        if (job < 176) { const int l = job / 88, strip = job % 88; float* cs = (float*)(ws + OFF_CS + l * SZ_CS);
            transpose_fold_strip<true>(tile, P.in[15] + (size_t)l * DM * 2 * DFF, 2 * DFF, (bf16_t*)(ws + OFF_WT_UP + l * SZ_WT_UP), DM, strip, P.in[13] + l * DM, P.in[14] + l * DM, nullptr, cs, cs + 2 * DFF, wv); }
        else { const int l = (job - 176) / 16, strip = (job - 176) % 16; float* cs = (float*)(ws + OFF_CS + l * SZ_CS) + 4 * DFF;
            transpose_fold_strip<false>(tile, P.in[21] + (size_t)l * DM * DM, DM, (bf16_t*)(ws + OFF_WT_GATE + l * SZ_WT_GATE), DM, strip, P.in[19] + l * DM, P.in[20] + l * DM, P.in[22] + l * DM, cs, cs + DM, wv); }
    }
    const size_t gt = (size_t)fresh_bid() * 512 + fresh_tid(wv), gs = (size_t)gridDim.x * blockDim.x;
    { const float* mix = P.in[3]; const float* sc = P.in[4]; const float* wo = P.in[6]; bf16_t* dst = (bf16_t*)(ws + OFF_WT_EOUT);
      for (size_t it = gt; it < (size_t)512 * DM; it += gs) { const int k = (int)(it >> 10), n = (int)(it & 1023), g = k >> 7;
          const float* mrow = mix + (size_t)k * 128; const float* srow = sc + g * 128; const float* wcol = wo + (size_t)(g * 128) * DM + n; float s = 0.f;
          for (int d = 0; d < 128; ++d) s += mrow[d] * srow[d] * wcol[(size_t)d * DM];
          dst[(size_t)n * DM + k] = f2bf(s); } }
    { const float* w = P.in[10]; bf16_t* dst = (bf16_t*)(ws + OFF_SGUW);
      for (size_t it = gt; it < (size_t)8 * 128 * 128; it += gs) { const int t = (int)((it >> 7) & 127), s = (int)(it & 127); dst[it] = (s <= t) ? f2bf(w[it]) : (bf16_t)0; } }
    } else {
    convert_bf16(P.in[0], (bf16_t*)(ws + OFF_ACTB), (size_t)MTOK * DM, wv);
    convert_bf16(P.in[1], (bf16_t*)(ws + OFF_PB), (size_t)2 * MTOK * PLE, wv);
    } }
}

#undef P
__device__ __forceinline__ void add8(float (&s)[8], const uint4 d, float sign) { float f[8]; unpack8(d, f);
#pragma unroll
    for (int j = 0; j < 8; ++j) s[j] += sign * f[j]; }
template <int W> __device__ __forceinline__ void pool_block(const bf16_t* __restrict__ Z, bf16_t* __restrict__ O, int r0, int c0) {
    const int t0 = r0 & (SEQL - 1);
    uint4 hist[W - 1], cur[8]; const uint4 z4 = make_uint4(0u, 0u, 0u, 0u);
#pragma unroll
    for (int j = 0; j < W - 1; ++j) hist[j] = (t0 - (W - 1) + j >= 0) ? *(const uint4*)(Z + (size_t)(r0 - (W - 1) + j) * EIN + c0) : z4;
#pragma unroll
    for (int i = 0; i < 8; ++i) cur[i] = *(const uint4*)(Z + (size_t)(r0 + i) * EIN + c0);
    float s[8];
#pragma unroll
    for (int j = 0; j < 8; ++j) s[j] = 0.f;
#pragma unroll
    for (int j = 0; j < W - 1; ++j) add8(s, hist[j], 1.f);
#pragma unroll
    for (int i = 0; i < 8; ++i) {
        add8(s, cur[i], 1.f);
        if (i >= 1) { if (i - W >= 0) add8(s, cur[i - W >= 0 ? i - W : 0], -1.f); else add8(s, hist[i - 1 >= 0 ? i - 1 : 0], -1.f); }
        const int cnt = (t0 + i + 1 < W) ? t0 + i + 1 : W; const float inv = 1.0f / (float)cnt; float x[8], o[8]; unpack8(cur[i], x);
#pragma unroll
        for (int j = 0; j < 8; ++j) o[j] = s[j] * inv - x[j];
        *(uint4*)(O + (size_t)(r0 + i) * DM + c0) = pack8(o);
    }
}
__device__ __forceinline__ void conv_block(const bf16_t* __restrict__ Z, const float* __restrict__ cw, bf16_t* __restrict__ O, int r0, int c0) {
    const bool hv = (r0 & (SEQL - 1)) != 0; const uint4 z4 = make_uint4(0u, 0u, 0u, 0u);
    uint4 cg[10], vv[10], bg[8];
#pragma unroll
    for (int j = 0; j < 10; ++j) { const bool ok = hv || j >= 2; const size_t ro = (size_t)(r0 - 2 + j) * EIN;
        cg[j] = ok ? *(const uint4*)(Z + ro + 1024 + c0) : z4; vv[j] = ok ? *(const uint4*)(Z + ro + 1536 + c0) : z4; }
#pragma unroll
    for (int i = 0; i < 8; ++i) bg[i] = *(const uint4*)(Z + (size_t)(r0 + i) * EIN + 512 + c0);
    float w[3][8];
#pragma unroll
    for (int k = 0; k < 3; ++k) { const float4 a = *(const float4*)(cw + k * 512 + c0), b = *(const float4*)(cw + k * 512 + c0 + 4);
        w[k][0] = a.x; w[k][1] = a.y; w[k][2] = a.z; w[k][3] = a.w; w[k][4] = b.x; w[k][5] = b.y; w[k][6] = b.z; w[k][7] = b.w; }
    float p2[8], p1[8];
    { float a[8], b[8]; unpack8(cg[0], a); unpack8(vv[0], b);
#pragma unroll
      for (int j = 0; j < 8; ++j) p2[j] = a[j] * b[j];
      unpack8(cg[1], a); unpack8(vv[1], b);
#pragma unroll
      for (int j = 0; j < 8; ++j) p1[j] = a[j] * b[j]; }
#pragma unroll
    for (int i = 0; i < 8; ++i) { float a[8], b[8], g[8], o[8]; unpack8(cg[i + 2], a); unpack8(vv[i + 2], b); unpack8(bg[i], g);
#pragma unroll
        for (int j = 0; j < 8; ++j) { const float p0 = a[j] * b[j]; o[j] = g[j] * (w[0][j] * p2[j] + w[1][j] * p1[j] + w[2][j] * p0); p2[j] = p1[j]; p1[j] = p0; }
        *(uint4*)(O + (size_t)(r0 + i) * DM + 512 + c0) = pack8(o); }
}
__device__ __forceinline__ void mixer0_phase(const bf16_t* __restrict__ Z, const float* __restrict__ cw, bf16_t* __restrict__ O, int wv) {
    const int tid = fresh_tid(wv), lane = tid & 63; const int nwaves = (int)gridDim.x * 8;
    for (int wi = fresh_bid() * 8 + wv; wi < 16384; wi += nwaves) {
        if (wi < 8192) { const int g = wi & 3, r0 = ((wi >> 2) * 4 + (lane >> 4)) * 8, c0 = g * 128 + (lane & 15) * 8;
            if (g == 0) pool_block<2>(Z, O, r0, c0); else if (g == 1) pool_block<4>(Z, O, r0, c0); else if (g == 2) pool_block<8>(Z, O, r0, c0); else pool_block<16>(Z, O, r0, c0); }
        else conv_block(Z, cw, O, (wi - 8192) * 8, lane * 8);
    }
}

__device__ __forceinline__ void ffn_fixup_phase(const float* __restrict__ side, const float* __restrict__ cw, const float* __restrict__ cb, bf16_t* __restrict__ H, int wv) {
    const size_t plane = (size_t)512 * 2 * DFF; const float* AT = side; const float* AH = side + plane; const float* GH = side + 2 * plane;
    const int total = 512 * 2 * (DFF / 4);
    for (int it = fresh_bid() * 512 + fresh_tid(wv); it < total; it += (int)gridDim.x * 512) {
        const int c = (it % (DFF / 4)) * 4, rr = (it / (DFF / 4)) & 1, blk = it / (2 * (DFF / 4)); const bool first = (blk & 31) == 0;
        const f32x4 z4 = (f32x4){0.f, 0.f, 0.f, 0.f};
        const f32x4 xh = *(const f32x4*)(AH + ((size_t)blk * 2 + rr) * DFF + c);
        const f32x4 t1 = first ? z4 : *(const f32x4*)(AT + ((size_t)(blk - 1) * 2 + 1) * DFF + c);
        const f32x4 t0 = first ? z4 : *(const f32x4*)(AT + ((size_t)(blk - 1) * 2 + 0) * DFF + c);
        const f32x4 h0 = *(const f32x4*)(AH + ((size_t)blk * 2 + 0) * DFF + c);
        const f32x4 x1 = rr ? h0 : t1, x2 = rr ? t1 : t0;
        const f32x4 w0 = *(const f32x4*)(cw + c), w1 = *(const f32x4*)(cw + DFF + c), w2 = *(const f32x4*)(cw + 2 * DFF + c), bb = *(const f32x4*)(cb + c);
        const f32x4 a = bb + w2 * xh + w1 * x1 + w0 * x2; const f32x4 g = *(const f32x4*)(GH + ((size_t)blk * 2 + rr) * DFF + c);
        const f32x2 g0 = pg8::gelu_pk((f32x2){a[0], a[1]}), g1 = pg8::gelu_pk((f32x2){a[2], a[3]});
        uint2 w; w.x = pk2(g0.x * g[0], g0.y * g[1]); w.y = pk2(g1.x * g[2], g1.y * g[3]);
        *(uint2*)(H + ((size_t)blk * 128 + rr) * DFF + c) = w;
    }
}

constexpr int SG_PITCH = 136;
__device__ __forceinline__ void sgu_phase(unsigned char* lds, const bf16_t* __restrict__ Z, const bf16_t* __restrict__ Wm, const float* __restrict__ lng, const float* __restrict__ lnb,
                                          const float* __restrict__ sb, bf16_t* __restrict__ UM, int wv) {
    const int tid = fresh_tid(wv), lane = tid & 63, wave = tid >> 6, l15 = lane & 15, quad = lane >> 4;
    f32x2* stats = (f32x2*)lds;
    bf16_t* Wl = (bf16_t*)(lds + 1024);
    bf16_t* vT = (bf16_t*)(lds + 1024 + 128 * SG_PITCH * 2);
    for (int ch = fresh_bid(); ch < MTOK / 128; ch += gridDim.x) {
        const size_t R0 = (size_t)ch * 128;
#pragma unroll 4
        for (int i = 0; i < 16; ++i) { const int row = wave * 16 + i; const bf16_t* vp = Z + (R0 + row) * 4096 + 2048; float s = 0.f, ss = 0.f;
#pragma unroll
            for (int q = 0; q < 4; ++q) { float f[8]; unpack8(*(const uint4*)(vp + q * 512 + lane * 8), f);
#pragma unroll
                for (int j = 0; j < 8; ++j) { s += f[j]; ss += f[j] * f[j]; } }
#pragma unroll
            for (int o = 32; o >= 1; o >>= 1) { s += __shfl_xor(s, o); ss += __shfl_xor(ss, o); }
            const float mean = s * (1.0f / 2048.0f), var = fmaxf(ss * (1.0f / 2048.0f) - mean * mean, 0.f);
            if (lane == 0) stats[row] = (f32x2){mean, 1.0f / sqrtf(var + LNEPS)}; }
        __syncthreads();
        const int r0 = 2 * lane; pg8::u32x4 wreg[4]; uint4 va[4], vb[4];
#define SGU_LOAD_HEAD(hh) do { _Pragma("unroll") for (int i = 0; i < 4; ++i) { const int idx = tid + i * 512; wreg[i] = *(const pg8::u32x4*)(Wm + (size_t)(hh) * 16384 + (idx >> 4) * 128 + (idx & 15) * 8); } \
            _Pragma("unroll") for (int gi = 0; gi < 4; ++gi) { const int gc = (hh) * 256 + (wave * 4 + gi) * 8; va[gi] = *(const uint4*)(Z + (R0 + r0) * 4096 + 2048 + gc); vb[gi] = *(const uint4*)(Z + (R0 + r0 + 1) * 4096 + 2048 + gc); } } while (0)
        SGU_LOAD_HEAD(0);
        for (int h = 0; h < 8; ++h) {
#pragma unroll
            for (int i = 0; i < 4; ++i) { const int idx = tid + i * 512; *(pg8::u32x4*)(Wl + (idx >> 4) * SG_PITCH + (idx & 15) * 8) = wreg[i]; }
            { const f32x2 st0 = stats[r0], st1 = stats[r0 + 1];
#pragma unroll
              for (int gi = 0; gi < 4; ++gi) { const int c0 = (wave * 4 + gi) * 8, gc = h * 256 + c0; float x0[8], x1[8]; unpack8(va[gi], x0); unpack8(vb[gi], x1);
                  const float4 g0 = *(const float4*)(lng + gc), g1 = *(const float4*)(lng + gc + 4), b0 = *(const float4*)(lnb + gc), b1 = *(const float4*)(lnb + gc + 4);
                  const float gg[8] = {g0.x, g0.y, g0.z, g0.w, g1.x, g1.y, g1.z, g1.w}, bb[8] = {b0.x, b0.y, b0.z, b0.w, b1.x, b1.y, b1.z, b1.w};
#pragma unroll
                  for (int j = 0; j < 8; ++j) { const float v0 = (x0[j] - st0.x) * st0.y * gg[j] + bb[j], v1 = (x1[j] - st1.x) * st1.y * gg[j] + bb[j];
                      *(unsigned*)(vT + (c0 + j) * SG_PITCH + r0) = pk2(v0, v1); } } }
            __syncthreads();
            uint2 ud[4][2];
#pragma unroll
            for (int tb = 0; tb < 4; ++tb)
#pragma unroll
                for (int cbi = 0; cbi < 2; ++cbi) ud[tb][cbi] = *(const uint2*)(Z + (R0 + tb * 16 + l15) * 4096 + h * 256 + wave * 32 + cbi * 16 + quad * 4);
            if (h < 7) SGU_LOAD_HEAD(h + 1);
            f32x4 acc[8][2];
#pragma unroll
            for (int tb = 0; tb < 8; ++tb) { acc[tb][0] = (f32x4){0.f, 0.f, 0.f, 0.f}; acc[tb][1] = (f32x4){0.f, 0.f, 0.f, 0.f}; }
            bf16x8 vf[2][4];
#pragma unroll
            for (int cbi = 0; cbi < 2; ++cbi)
#pragma unroll
                for (int ks = 0; ks < 4; ++ks) vf[cbi][ks] = *(const bf16x8*)(vT + (wave * 32 + cbi * 16 + l15) * SG_PITCH + ks * 32 + quad * 8);
#pragma unroll
            for (int tb = 0; tb < 8; ++tb)
#pragma unroll
                for (int ks = 0; ks < 4; ++ks) if (ks <= tb / 2) { const bf16x8 wf = *(const bf16x8*)(Wl + (tb * 16 + l15) * SG_PITCH + ks * 32 + quad * 8);
                    acc[tb][0] = __builtin_amdgcn_mfma_f32_16x16x32_bf16(vf[0][ks], wf, acc[tb][0], 0, 0, 0);
                    acc[tb][1] = __builtin_amdgcn_mfma_f32_16x16x32_bf16(vf[1][ks], wf, acc[tb][1], 0, 0, 0); }
#pragma unroll
            for (int tb = 0; tb < 8; ++tb) { const int t = tb * 16 + l15; const float bias = sb[h * 128 + t];
#pragma unroll
                for (int cbi = 0; cbi < 2; ++cbi) { const int c = h * 256 + wave * 32 + cbi * 16 + quad * 4; const uint2 u2 = (tb < 4) ? ud[tb < 4 ? tb : 0][cbi] : *(const uint2*)(Z + (R0 + t) * 4096 + c); const f32x4 a = acc[tb][cbi];
                    uint2 w; w.x = pk2(bflo(u2.x) * (a[0] + bias), bfhi(u2.x) * (a[1] + bias)); w.y = pk2(bflo(u2.y) * (a[2] + bias), bfhi(u2.y) * (a[3] + bias));
                    *(uint2*)(UM + (R0 + t) * 2048 + c) = w; } }
            __syncthreads();
        }
    }
}

__device__ __forceinline__ void stagger(int ticks) {
    if (ticks > 0 && (fresh_bid() & 7) >= 4) { const unsigned long long t0 = __builtin_amdgcn_s_memrealtime();
        while (__builtin_amdgcn_s_memrealtime() - t0 < (unsigned long long)ticks) __builtin_amdgcn_s_sleep(32); }
}
#ifndef STAG_F32
#define STAG_F32 0
#endif
#ifndef STAG_B16
#define STAG_B16 0
#endif
typedef const __attribute__((address_space(4))) Params* KParamsPtr;
__device__ __forceinline__ KParamsPtr kparams() { KParamsPtr p = (KParamsPtr)__builtin_amdgcn_kernarg_segment_ptr(); asm volatile("" : "+s"(p)); return p; }
#define P (*kparams())
__global__ void __launch_bounds__(512, 2) hybrid_fwd(Params P_unused) {
    extern __shared__ __attribute__((aligned(16))) unsigned char lds[];
    cg::grid_group grid = cg::this_grid();
    PG8_LAS unsigned char* ldsg = (PG8_LAS unsigned char*)lds;
#define ws (P.ws)
#define R (P.out)
    const int G = (int)gridDim.x; const int wv = __builtin_amdgcn_readfirstlane((int)threadIdx.x >> 6);
#define ACTB ((bf16_t*)(ws + OFF_ACTB))
#define PB ((bf16_t*)(ws + OFF_PB))
#define ZB ((bf16_t*)(ws + OFF_ZBUF))
#define HFB ((bf16_t*)(ws + OFF_HF))
#define PPB ((bf16_t*)(ws + OFF_ZBUF))

#define barw ((unsigned*)(ws + OFF_BAR))
    { const int t0 = fresh_tid(wv); if (blockIdx.x == 0) { unsigned* bw = barw; for (int i = t0; i < XCD_BAR_WORDS; i += 512) bw[i] = 0u; }
      if (t0 < 4) ((volatile LAS unsigned*)(ldsg + pg8::STAGE_BYTES))[t0] = 0u; }
    prep_phase(kparams(), (float*)lds, wv);
    grid.sync();
    (void)xcd_barrier_post(barw, (volatile LAS unsigned*)(ldsg + pg8::STAGE_BYTES), fresh_tid(wv));
#define GSYNC() do { XcdBarrier xb_; xb_.bar = barw; xb_.x = xb_xcc_id(); xb_.st = (volatile LAS unsigned*)(ldsg + pg8::STAGE_BYTES); xcd_barrier(xb_, fresh_tid(wv)); } while (0)

#define ST1 ((float*)(ws + OFF_ST))
#define ST2 ((float*)(ws + OFF_ST + SZ_ST))
#define xl ((PG8_LAS float*)(ldsg + XL_OFF))
    for (int layer = 0; layer < 2; ++layer) {
#define CS ((const float*)(ws + OFF_CS + layer * SZ_CS))
#define g1 (P.in[13] + layer * DM)
#define b1 (P.in[14] + layer * DM)
#define g2 (P.in[19] + layer * DM)
#define b2 (P.in[20] + layer * DM)
        if (layer == 0) {
            { stagger(STAG_B16); pg8::Gemm g{ACTB, (const bf16_t*)(ws + OFF_WT_EIN), MTOK, EIN, DM}; pg8::StaticOrder S; S.init(MTOK, EIN, G, fresh_bid());
              pg8::EpiBf16<0> E{ZB, EIN, nullptr, 0, 0}; pg8::gemm_phase<pg8::EpiBf16<0>, pg8::StaticOrder>(ldsg, g, S, E, nullptr, wv); }
            GSYNC();
            mixer0_phase(ZB, P.in[5], HFB, wv);
            GSYNC();
            { stagger(STAG_F32); pg8::Gemm g{HFB, (const bf16_t*)(ws + OFF_WT_EOUT), MTOK, DM, DM}; pg8::StaticOrder S; S.init(MTOK, DM, G, fresh_bid());
              pg8::EpiResLn<false> E{P.in[0], R, ACTB, DM, nullptr, nullptr, nullptr, ST1, xl}; pg8::gemm_phase<pg8::EpiResLn<false>, pg8::StaticOrder>(ldsg, g, S, E, nullptr, wv); }
        } else {
            { stagger(STAG_B16); pg8::Gemm g{HFB, (const bf16_t*)(ws + OFF_WT_OIN), MTOK, 4096, DM}; pg8::StaticOrder S; S.init(MTOK, 4096, G, fresh_bid());
              pg8::EpiBf16<1> E{ZB, 4096, nullptr, 0, 0}; pg8::gemm_phase<pg8::EpiBf16<1>, pg8::StaticOrder>(ldsg, g, S, E, nullptr, wv); }
            GSYNC();
            sgu_phase(lds, ZB, (const bf16_t*)(ws + OFF_SGUW), P.in[8], P.in[9], P.in[11], HFB, wv);
            GSYNC();
            { stagger(STAG_F32); pg8::Gemm g{HFB, (const bf16_t*)(ws + OFF_WT_OOUT), MTOK, DM, 2048}; pg8::StaticOrder S; S.init(MTOK, DM, G, fresh_bid());
              pg8::EpiResLn<false> E{R, R, ACTB, DM, nullptr, nullptr, nullptr, ST1, xl}; pg8::gemm_phase<pg8::EpiResLn<false>, pg8::StaticOrder>(ldsg, g, S, E, nullptr, wv); }
        }
        GSYNC();
        { const float* cw = P.in[16] + (size_t)layer * 3 * DFF; const float* cb = P.in[17] + (size_t)layer * DFF; float* side = (float*)(ws + OFF_HF);
          { stagger(STAG_B16); pg8::Gemm g{ACTB, (const bf16_t*)(ws + OFF_WT_UP + layer * SZ_WT_UP), MTOK, 2 * DFF, DM}; pg8::StaticOrder S; S.init(MTOK, 2 * DFF, G, fresh_bid());
            pg8::EpiFfn E{ZB, cw, cb, side, ST1, CS, CS + 2 * DFF, DFF}; pg8::gemm_phase<pg8::EpiFfn, pg8::StaticOrder>(ldsg, g, S, E, nullptr, wv); }
          GSYNC();
          ffn_fixup_phase(side, cw, cb, ZB, wv);
          GSYNC();
          { stagger(STAG_F32); pg8::Gemm g{ZB, (const bf16_t*)(ws + OFF_WT_DOWN + layer * SZ_WT_DOWN), MTOK, DM, DFF}; pg8::StaticOrder S; S.init(MTOK, DM, G, fresh_bid());
            pg8::EpiResLn<true> E{R, R, ACTB, DM, ST1, g1, b1, ST2, xl}; pg8::gemm_phase<pg8::EpiResLn<true>, pg8::StaticOrder>(ldsg, g, S, E, nullptr, wv); }
          GSYNC(); }
        { pg8::Gemm g{PB + (size_t)layer * MTOK * PLE, (const bf16_t*)(ws + OFF_WT_PROJ + layer * SZ_WT_PROJ), MTOK, DM, PLE}; pg8::StaticOrder S; S.init(MTOK, DM, G, fresh_bid());
          pg8::EpiBf16<0> E{PPB, DM, nullptr, 0, 0}; pg8::gemm_phase<pg8::EpiBf16<0>, pg8::StaticOrder>(ldsg, g, S, E, nullptr, wv); }
        asm volatile("s_waitcnt vmcnt(0)" ::: "memory"); __syncthreads(); __builtin_amdgcn_fence(__ATOMIC_ACQUIRE, "agent"); asm volatile("s_waitcnt vmcnt(0)" ::: "memory");
        { stagger(STAG_F32); pg8::Gemm g{ACTB, (const bf16_t*)(ws + OFF_WT_GATE + layer * SZ_WT_GATE), MTOK, DM, DM}; pg8::StaticOrder S; S.init(MTOK, DM, G, fresh_bid());
          pg8::EpiPle E{R, PPB, ST2, CS + 4 * DFF, CS + 4 * DFF + DM, g2, b2, (layer == 0) ? HFB : nullptr, DM}; pg8::gemm_phase<pg8::EpiPle, pg8::StaticOrder>(ldsg, g, S, E, nullptr, wv); }
        if (layer == 0) GSYNC();
    }
}

#undef ws
#undef R
#undef ACTB
#undef PB
#undef ZB
#undef HFB
#undef PPB
#undef barw
#undef ST1
#undef ST2
#undef xl
#undef CS
#undef g1
#undef b1
#undef g2
#undef b2
#undef P
extern "C" void kernel_launch(void* const* d_in, const int* in_sizes, int n_in, void* d_out, int out_size, void* d_ws, size_t ws_size, hipStream_t stream) {
    static int grid_blocks = 0;
    if (grid_blocks == 0) {
        if (n_in != 24 || out_size != MTOK * DM || ws_size < WS_END) { fprintf(stderr, "kernel_launch: unexpected shapes (n_in %d out %d ws %zu need %zu)\n", n_in, out_size, ws_size, (size_t)WS_END); grid_blocks = -1; return; }
        int dev = 0, cus = 0, per_cu = 0;
        hipGetDevice(&dev); hipDeviceGetAttribute(&cus, hipDeviceAttributeMultiprocessorCount, dev);
        if (hipFuncSetAttribute((const void*)hybrid_fwd, hipFuncAttributeMaxDynamicSharedMemorySize, LDS_BYTES) != hipSuccess) { fprintf(stderr, "kernel_launch: hipFuncSetAttribute failed\n"); grid_blocks = -1; return; }
        if (hipOccupancyMaxActiveBlocksPerMultiprocessor(&per_cu, (const void*)hybrid_fwd, 512, LDS_BYTES) != hipSuccess || per_cu < 1) { fprintf(stderr, "kernel_launch: occupancy query gave %d\n", per_cu); per_cu = 1; }
        (void)hipGetLastError();
        grid_blocks = cus * 1;
    }
    if (grid_blocks < 0) return;
    Params p{};
    for (int i = 0; i < 24; ++i) p.in[i] = (const float*)d_in[i];
    p.out = (float*)d_out; p.ws = (unsigned char*)d_ws;
    void* args[] = {&p};
    hipError_t e = hipLaunchCooperativeKernel((const void*)hybrid_fwd, dim3(grid_blocks), dim3(512), args, LDS_BYTES, stream);
    if (e != hipSuccess) fprintf(stderr, "cooperative launch failed: %s (grid %d)\n", hipGetErrorString(e), grid_blocks);
}
```
